# Optimizing an MI355X kernel written in HIP

```python
import math
import jax, jax.numpy as jnp
from jax import lax
import numpy as np

D_MODEL = 1024
BATCH = 8
SEQ = 8192
DEPTH = 1

N_META = 16
GRID_W = 64
SSM_GROUP = 16
SSM_STATE = 64
SSM_WIDTH = D_MODEL // 2
SSM_GROUPS = SSM_WIDTH // SSM_GROUP
HEAD_DIM = 64
N_HEADS = D_MODEL // HEAD_DIM
N_KV_HEADS = N_HEADS // 4
Q_WIDTH = N_HEADS * HEAD_DIM
KV_WIDTH = N_KV_HEADS * HEAD_DIM
IN_WIDTH = SSM_WIDTH + Q_WIDTH + 2 * KV_WIDTH + 2 * D_MODEL
D_FF = 4 * D_MODEL
Q_BLOCK = 128
ROPE_THETA = 10000.0
NORM_EPS = 1e-6
DT_MIN = 1e-3
DT_MAX = 1e-1
EIG_RE_MAX = -1e-4

kernel_name = "hybrid_s5_gqa_axial_gated_encoder"


def rms_norm(x, g):
    xf = x.astype(jnp.float32)
    y = xf * lax.rsqrt(jnp.mean(xf * xf, axis=-1, keepdims=True) + NORM_EPS)
    return (y * g.astype(jnp.float32)).astype(x.dtype)


def axial_rope_tables(n_total):
    n_real = n_total - N_META
    rows = n_real // GRID_W
    row_id = jnp.repeat(jnp.arange(rows, dtype=jnp.float32), GRID_W)
    col_id = jnp.tile(jnp.arange(GRID_W, dtype=jnp.float32), rows)
    pairs_per_axis = HEAD_DIM // 4
    inv_freq = ROPE_THETA ** (-jnp.arange(pairs_per_axis, dtype=jnp.float32) / pairs_per_axis)
    ang = jnp.concatenate([row_id[:, None] * inv_freq, col_id[:, None] * inv_freq], axis=-1)
    ang = jnp.concatenate([jnp.zeros((N_META, HEAD_DIM // 2), jnp.float32), ang], axis=0)
    return jnp.cos(ang), jnp.sin(ang)


def apply_rope(t, cos, sin):
    tf = t.astype(jnp.float32).reshape(t.shape[:-1] + (HEAD_DIM // 2, 2))
    t0, t1 = tf[..., 0], tf[..., 1]
    c = cos[:, None, :]
    s = sin[:, None, :]
    out = jnp.stack([t0 * c - t1 * s, t0 * s + t1 * c], axis=-1)
    return out.reshape(t.shape)


def gqa_attention(q, k, v):
    b, l = q.shape[0], q.shape[1]
    rep = N_HEADS // N_KV_HEADS
    scale = HEAD_DIM ** -0.5
    qg = q.reshape(b, l, N_KV_HEADS, rep, HEAD_DIM)

    def attend(qb):
        s = jnp.einsum('bqgrd,bkgd->bgrqk', qb, k) * scale
        p = jax.nn.softmax(s, axis=-1)
        return jnp.einsum('bgrqk,bkgd->bqgrd', p, v)

    out_meta = attend(qg[:, :N_META]).reshape(b, N_META, Q_WIDTH)
    n_real = l - N_META
    n_blk = n_real // Q_BLOCK
    q_blocks = qg[:, N_META:].reshape(b, n_blk, Q_BLOCK, N_KV_HEADS, rep, HEAD_DIM)
    q_blocks = jnp.transpose(q_blocks, (1, 0, 2, 3, 4, 5))
    out_real = lax.map(attend, q_blocks)
    out_real = jnp.transpose(out_real, (1, 0, 2, 3, 4, 5)).reshape(b, n_real, Q_WIDTH)
    return jnp.concatenate([out_meta, out_real], axis=1)


def _complex_scan_combine(e1, e2):
    a1r, a1i, b1r, b1i = e1
    a2r, a2i, b2r, b2i = e2
    return (a1r * a2r - a1i * a2i,
            a1r * a2i + a1i * a2r,
            a2r * b1r - a2i * b1i + b2r,
            a2r * b1i + a2i * b1r + b2i)


def s5_direction(uf, a_re, a_im, log_dt, b_re, b_im, c_re, c_im, reverse):
    l = uf.shape[1]
    f32 = jnp.float32
    dt = jnp.exp(log_dt.astype(f32))[:, None]
    lam_re = jnp.minimum(a_re.astype(f32), EIG_RE_MAX)
    lam_im = a_im.astype(f32)
    mag = jnp.exp(lam_re * dt)
    ang = lam_im * dt
    lb_re = mag * jnp.cos(ang)
    lb_im = mag * jnp.sin(ang)
    num_re = lb_re - 1.0
    num_im = lb_im
    den = lam_re * lam_re + lam_im * lam_im
    f_re = (num_re * lam_re + num_im * lam_im) / den
    f_im = (num_im * lam_re - num_re * lam_im) / den
    br = b_re.astype(f32)
    bi = b_im.astype(f32)
    bb_re = f_re[..., None] * br - f_im[..., None] * bi
    bb_im = f_re[..., None] * bi + f_im[..., None] * br
    bu_re = jnp.einsum('blgp,gnp->blgn', uf, bb_re)
    bu_im = jnp.einsum('blgp,gnp->blgn', uf, bb_im)
    shape_a = (1, l) + lb_re.shape
    a_seq_re = jnp.broadcast_to(lb_re, shape_a)
    a_seq_im = jnp.broadcast_to(lb_im, shape_a)
    _, _, x_re, x_im = lax.associative_scan(
        _complex_scan_combine, (a_seq_re, a_seq_im, bu_re, bu_im), reverse=reverse, axis=1)
    return (jnp.einsum('blgn,gpn->blgp', x_re, c_re.astype(f32))
            - jnp.einsum('blgn,gpn->blgp', x_im, c_im.astype(f32)))


def s5_bidirectional(u, a_re, a_im, log_dt, b_re, b_im, c_re, c_im, d):
    bsz, l = u.shape[0], u.shape[1]
    uf = u.astype(jnp.float32).reshape(bsz, l, SSM_GROUPS, SSM_GROUP)
    y = uf * d.astype(jnp.float32).reshape(SSM_GROUPS, SSM_GROUP)
    for direction in range(2):
        y = y + s5_direction(uf, a_re[direction], a_im[direction], log_dt[direction],
                             b_re[direction], b_im[direction], c_re[direction], c_im[direction],
                             reverse=(direction == 1))
    return y.reshape(bsz, l, SSM_WIDTH)


def setup_inputs(seed: int = 0) -> dict:
    key = jax.random.key(seed)
    ks = jax.random.split(key, 24)
    f32 = jnp.float32

    def nrm(k, shape, scale):
        return jax.random.normal(k, shape, f32) * scale

    def gain(k, shape):
        return 1.0 + 0.02 * jax.random.normal(k, shape, f32)

    n_idx = jnp.arange(SSM_STATE, dtype=f32)
    ssm_shape = (DEPTH, 2, SSM_GROUPS, SSM_STATE)
    return {
        "x": jax.random.normal(ks[0], (BATCH, SEQ, D_MODEL), f32),
        "meta_tokens": nrm(ks[1], (N_META, D_MODEL), 1.0),
        "norm_mix_g": gain(ks[2], (DEPTH, D_MODEL)),
        "w_in": nrm(ks[3], (DEPTH, D_MODEL, IN_WIDTH), D_MODEL ** -0.5),
        "ssm_a_re": -0.5 + 0.01 * jax.random.normal(ks[4], ssm_shape, f32),
        "ssm_a_im": jnp.pi * n_idx + 0.01 * jax.random.normal(ks[5], ssm_shape, f32),
        "ssm_log_dt": jax.random.uniform(ks[6], (DEPTH, 2, SSM_GROUPS), f32,
                                         minval=math.log(DT_MIN), maxval=math.log(DT_MAX)),
        "ssm_b_re": nrm(ks[7], (DEPTH, 2, SSM_GROUPS, SSM_STATE, SSM_GROUP), (2 * SSM_GROUP) ** -0.5),
        "ssm_b_im": nrm(ks[8], (DEPTH, 2, SSM_GROUPS, SSM_STATE, SSM_GROUP), (2 * SSM_GROUP) ** -0.5),
        "ssm_c_re": nrm(ks[9], (DEPTH, 2, SSM_GROUPS, SSM_GROUP, SSM_STATE), SSM_STATE ** -0.5),
        "ssm_c_im": nrm(ks[10], (DEPTH, 2, SSM_GROUPS, SSM_GROUP, SSM_STATE), SSM_STATE ** -0.5),
        "ssm_d": nrm(ks[11], (DEPTH, SSM_WIDTH), 1.0),
        "w_glu": nrm(ks[12], (DEPTH, SSM_WIDTH, SSM_WIDTH), SSM_WIDTH ** -0.5),
        "b_glu": nrm(ks[13], (DEPTH, SSM_WIDTH), 0.02),
        "q_norm_g": gain(ks[14], (DEPTH, HEAD_DIM)),
        "k_norm_g": gain(ks[15], (DEPTH, HEAD_DIM)),
        "w_ssm_proj": nrm(ks[16], (DEPTH, SSM_WIDTH, D_MODEL), SSM_WIDTH ** -0.5),
        "w_attn_proj": nrm(ks[17], (DEPTH, Q_WIDTH, D_MODEL), Q_WIDTH ** -0.5),
        "w_out": nrm(ks[18], (DEPTH, D_MODEL, D_MODEL), D_MODEL ** -0.5),
        "norm_mlp_g": gain(ks[19], (DEPTH, D_MODEL)),
        "w_mlp_in": nrm(ks[20], (DEPTH, D_MODEL, D_FF), D_MODEL ** -0.5),
        "w_mlp_out": nrm(ks[21], (DEPTH, D_FF, D_MODEL), D_FF ** -0.5),
        "norm_final_g": gain(ks[22], (D_MODEL,)),
    }


def reference(x, meta_tokens, norm_mix_g, w_in, ssm_a_re, ssm_a_im, ssm_log_dt,
              ssm_b_re, ssm_b_im, ssm_c_re, ssm_c_im, ssm_d, w_glu, b_glu,
              q_norm_g, k_norm_g, w_ssm_proj, w_attn_proj, w_out,
              norm_mlp_g, w_mlp_in, w_mlp_out, norm_final_g):
    dtype = x.dtype
    bsz = x.shape[0]
    meta = jnp.broadcast_to(meta_tokens.astype(dtype)[None], (bsz, N_META, D_MODEL))
    h_res = jnp.concatenate([meta, x], axis=1)
    l = h_res.shape[1]
    cos, sin = axial_rope_tables(l)
    split_at = [SSM_WIDTH, SSM_WIDTH + Q_WIDTH, SSM_WIDTH + Q_WIDTH + KV_WIDTH,
                SSM_WIDTH + Q_WIDTH + 2 * KV_WIDTH, SSM_WIDTH + Q_WIDTH + 2 * KV_WIDTH + D_MODEL]

    for i in range(DEPTH):
        h = rms_norm(h_res, norm_mix_g[i])
        proj = h @ w_in[i]
        u, q, k, v, g_ssm, g_attn = jnp.split(proj, split_at, axis=-1)

        y = s5_bidirectional(u, ssm_a_re[i], ssm_a_im[i], ssm_log_dt[i], ssm_b_re[i], ssm_b_im[i],
                             ssm_c_re[i], ssm_c_im[i], ssm_d[i])
        z = jax.nn.gelu(y, approximate=False)
        y_ssm = z * jax.nn.sigmoid(z @ w_glu[i].astype(jnp.float32) + b_glu[i].astype(jnp.float32))

        q = rms_norm(q.reshape(bsz, l, N_HEADS, HEAD_DIM), q_norm_g[i])
        k = rms_norm(k.reshape(bsz, l, N_KV_HEADS, HEAD_DIM), k_norm_g[i])
        q = apply_rope(q, cos, sin)
        k = apply_rope(k, cos, sin)
        v = v.reshape(bsz, l, N_KV_HEADS, HEAD_DIM).astype(jnp.float32)
        y_attn = gqa_attention(q, k, v)

        merged = (jax.nn.sigmoid(g_ssm.astype(jnp.float32)) * (y_ssm.astype(dtype) @ w_ssm_proj[i])
                  + jax.nn.sigmoid(g_attn.astype(jnp.float32)) * (y_attn.astype(dtype) @ w_attn_proj[i]))
        h_res = h_res + (merged.astype(dtype) @ w_out[i]).astype(dtype)

        h2 = rms_norm(h_res, norm_mlp_g[i])
        h_res = h_res + (jnp.square(jax.nn.relu(h2 @ w_mlp_in[i])) @ w_mlp_out[i]).astype(dtype)

    out = rms_norm(h_res, norm_final_g)
    return out[:, N_META:]
```

```cpp
#include <hip/hip_runtime.h>
#include <hip/hip_cooperative_groups.h>
#include <hip/hip_bf16.h>
#include <cstdio>
#include <cstdint>
#include <cmath>
namespace cg = cooperative_groups;

constexpr int BATCH = 8, SEQ = 8192, D = 1024, NMETA = 16, NH = 16, NKVH = 4, HD = 64, FF = 4096;
constexpr int M = BATCH * SEQ;
constexpr int INW = 4096;
constexpr int SSMW = 512, NGRP = 32, NST = 64, GP = 16;
constexpr int CT = 32;
constexpr int NCH = SEQ / CT;
constexpr int CROWS = BATCH * NCH;
constexpr int KCAT = CT * GP + 4 * NST;
constexpr int KVR = SEQ + 64;
constexpr float NORM_EPS = 1e-6f;
constexpr int QP = 1536;
constexpr float C2Q = 0.125f * 1.4426950408889634f;

namespace pg8 {
#define PG8_LAS __attribute__((address_space(3)))
typedef unsigned short bf16_t;
typedef short bf16x8 __attribute__((ext_vector_type(8)));
typedef float f32x4 __attribute__((ext_vector_type(4)));
typedef unsigned u32x4 __attribute__((ext_vector_type(4)));
typedef unsigned u32x2 __attribute__((ext_vector_type(2)));
constexpr int BM = 256, BK = 64, HALF = 128, HTB = HALF * BK * 2  , STAGE_BYTES = 8 * HTB, NXCD = 8, WGM = 4;

__host__ __device__ __forceinline__ int lds_byte(int r, int c) { const int st = (r >> 4) * 2 + (c >> 5), rr = r & 15, cc = c & 31, ob = rr * 64 + cc * 2; return st * 1024 + (ob ^ (((ob >> 9) & 1) << 5)); }
__host__ __device__ __forceinline__ void stage_rc(int b, int& R, int& C) { const int st = b / 1024, sb = b % 1024, swz = sb ^ (((sb >> 9) & 1) << 5); R = (st >> 1) * 16 + swz / 64; C = (st & 1) * 32 + (swz % 64) / 2; }
__host__ __device__ __forceinline__ int perm32(int rho) { const int n = rho >> 4, i = rho & 15; return 8 * (i >> 2) + 4 * n + (i & 3); }

struct Unit { int pm, pn, g; };
struct Gemm { const bf16_t* A; const bf16_t* Bt; int K, lda, ldb; size_t sA, sB; };

struct StaticOrder {
    int nM, nN, nwg, G, c, mpb;
    __host__ __device__ void init(int Mtot, int N, int G_, int c_, int mpb_) { nM = Mtot / BM; nN = N / BM; nwg = nM * nN; G = G_; c = c_; mpb = mpb_; }
    __host__ __device__ bool next(int i, Unit& u) const {
        const long L = (long)i * G + c; if (L >= nwg) return false;
        int wgid = (int)L; { const int q = nwg / NXCD, r = nwg % NXCD, xcd = wgid % NXCD, off = wgid / NXCD; wgid = (xcd < r ? xcd * (q + 1) : r * (q + 1) + (xcd - r) * q) + off; }
        const int nig = WGM * nN, gid = wgid / nig, fm = gid * WGM, gsz = (nM - fm) < WGM ? (nM - fm) : WGM;
        const int pmt = fm + ((wgid % nig) % gsz); u.pn = (wgid % nig) / gsz; u.g = pmt / mpb; u.pm = pmt % mpb; return true;
    }
};

__device__ __forceinline__ unsigned cvt_pk_bf16(float lo, float hi) { unsigned r; asm volatile("v_cvt_pk_bf16_f32 %0, %1, %2" : "=v"(r) : "v"(lo), "v"(hi)); return r; }
typedef float f32x2 __attribute__((ext_vector_type(2)));
__device__ __forceinline__ f32x2 gelu_pk(f32x2 v) {
    const f32x2 av = __builtin_elementwise_abs(v), d = av * 0.2316418882f + 1.0f;
    f32x2 t; t.x = __builtin_amdgcn_rcpf(d.x); t.y = __builtin_amdgcn_rcpf(d.y);
    f32x2 q = t * 0.5307027145f + (-0.7265760135f); q = q * t + 0.7107068705f; q = q * t + (-0.142248368f); q = q * t + 0.127414796f; q = q * t;
    const f32x2 s = (v * v) * (-0.72134752044f);
    f32x2 e; e.x = __builtin_amdgcn_exp2f(s.x); e.y = __builtin_amdgcn_exp2f(s.y);
    const f32x2 m = v * (q * e), r = v - m;
    f32x2 o; o.x = v.x < 0.f ? m.x : r.x; o.y = v.y < 0.f ? m.y : r.y; return o;
}
__device__ __forceinline__ float sigmoidf_(float x) { return __builtin_amdgcn_rcpf(1.0f + __builtin_amdgcn_exp2f(-1.4426950408889634f * x)); }
__device__ __forceinline__ float bf_lo(unsigned w) { return __uint_as_float(w << 16); }
__device__ __forceinline__ float bf_hi(unsigned w) { return __uint_as_float(w & 0xffff0000u); }
__device__ __forceinline__ u32x4 pack8(const f32x4 a, const f32x4 b) { u32x4 w; w.x = cvt_pk_bf16(a[0], a[1]); w.y = cvt_pk_bf16(a[2], a[3]); w.z = cvt_pk_bf16(b[0], b[1]); w.w = cvt_pk_bf16(b[2], b[3]); return w; }


struct EpiInProj {
    static constexpr bool PERM = true, AFTER_DRAIN = false; static constexpr int MID_T = -1;
    bf16_t* Acat; bf16_t* Q; bf16_t* Kb; bf16_t* Vb; bf16_t* Gt; const float* qg; const float* kg; const float* rope;
    __device__ __forceinline__ void operator()(const f32x4 (&acc)[2][2][4][2], const Unit& u, int wr, int wc, int fr, int fq) const {
        const int pn = u.pn, rowb = u.pm * BM + wr * 64 + fr;
        if (pn < 2) {
#pragma unroll
            for (int ai = 0; ai < 2; ++ai)
#pragma unroll
                for (int m = 0; m < 4; ++m) { const int row = rowb + ai * HALF + m * 16;
#pragma unroll
                    for (int bj = 0; bj < 2; ++bj) { const int g = 16 * pn + 4 * wc + 2 * bj + (fq >> 1);
                        bf16_t* dst = Acat + ((size_t)g * CROWS + (row >> 5)) * KCAT + (row & 31) * 16 + 8 * (fq & 1);
                        *(u32x4*)dst = pack8(acc[ai][bj][m][0], acc[ai][bj][m][1]); } }
        } else if (pn < 7) {
            const bool isq = pn < 6; const float* gsrc = isq ? qg : kg;
            f32x4 gq[2][2];
#pragma unroll
            for (int bj = 0; bj < 2; ++bj)
#pragma unroll
                for (int n = 0; n < 2; ++n) gq[bj][n] = *(const f32x4*)(gsrc + 32 * bj + 8 * fq + 4 * n);
            const float post = isq ? C2Q : 1.0f;
#pragma unroll
            for (int ai = 0; ai < 2; ++ai) {
                f32x4 cs[4][2][2];
#pragma unroll
                for (int m = 0; m < 4; ++m) { const int t = (rowb + ai * HALF + m * 16) & (SEQ - 1);
#pragma unroll
                    for (int bj = 0; bj < 2; ++bj) { const int pos = bj ? (t & 63) : (t >> 6); const f32x4* rp = (const f32x4*)(rope + (pos * 16 + 4 * fq) * 2); cs[m][bj][0] = rp[0]; cs[m][bj][1] = rp[1]; } }
                asm volatile("" ::: "memory");
#pragma unroll
                for (int m = 0; m < 4; ++m) { const int row = rowb + ai * HALF + m * 16, t = row & (SEQ - 1), b = row >> 13;
                    float ss = 0.f;
#pragma unroll
                    for (int bj = 0; bj < 2; ++bj)
#pragma unroll
                        for (int n = 0; n < 2; ++n) { const f32x4 x = acc[ai][bj][m][n]; ss += (x[0] * x[0] + x[1] * x[1]) + (x[2] * x[2] + x[3] * x[3]); }
                    ss += __shfl_xor(ss, 16); ss += __shfl_xor(ss, 32);
                    const float rn = __builtin_amdgcn_rsqf(ss * (1.0f / 64.0f) + NORM_EPS) * post;
                    bf16_t* dst = isq ? Q + (size_t)row * QP + ((pn - 2) * 4 + wc) * 64 + 8 * fq
                                      : Kb + ((size_t)b * KVR + t) * 256 + wc * 64 + 8 * fq;
#pragma unroll
                    for (int bj = 0; bj < 2; ++bj) {
                        const f32x4 cs0 = cs[m][bj][0], cs1 = cs[m][bj][1];
                        const f32x4 v0 = acc[ai][bj][m][0] * gq[bj][0] * rn, v1 = acc[ai][bj][m][1] * gq[bj][1] * rn;
                        f32x4 o0, o1;
                        o0[0] = v0[0] * cs0[0] - v0[1] * cs0[1]; o0[1] = v0[0] * cs0[1] + v0[1] * cs0[0]; o0[2] = v0[2] * cs0[2] - v0[3] * cs0[3]; o0[3] = v0[2] * cs0[3] + v0[3] * cs0[2];
                        o1[0] = v1[0] * cs1[0] - v1[1] * cs1[1]; o1[1] = v1[0] * cs1[1] + v1[1] * cs1[0]; o1[2] = v1[2] * cs1[2] - v1[3] * cs1[3]; o1[3] = v1[2] * cs1[3] + v1[3] * cs1[2];
                        *(u32x4*)(dst + 32 * bj) = pack8(o0, o1); } } }
        } else if (pn == 7) {
#pragma unroll
            for (int ai = 0; ai < 2; ++ai)
#pragma unroll
                for (int m = 0; m < 4; ++m) { const int row = rowb + ai * HALF + m * 16, t = row & (SEQ - 1), b = row >> 13;
                    bf16_t* dst = Vb + ((size_t)b * KVR + t) * 256 + wc * 64 + 8 * fq;
#pragma unroll
                    for (int bj = 0; bj < 2; ++bj) *(u32x4*)(dst + 32 * bj) = pack8(acc[ai][bj][m][0], acc[ai][bj][m][1]); }
        } else {
#pragma unroll
            for (int ai = 0; ai < 2; ++ai)
#pragma unroll
                for (int m = 0; m < 4; ++m) { const int row = rowb + ai * HALF + m * 16;
                    bf16_t* dst = Gt + (size_t)row * 2048 + (pn - 8) * 256 + wc * 64 + 8 * fq;
#pragma unroll
                    for (int bj = 0; bj < 2; ++bj) { f32x4 a = acc[ai][bj][m][0], c = acc[ai][bj][m][1];
#pragma unroll
                        for (int e = 0; e < 4; ++e) { a[e] = sigmoidf_(a[e]); c[e] = sigmoidf_(c[e]); }
                        *(u32x4*)(dst + 32 * bj) = pack8(a, c); } }
        }
    }
};
struct EpiF32 {
    static constexpr bool PERM = false, AFTER_DRAIN = false; static constexpr int MID_T = -1;
    float* O; int ldc; size_t sO;
    __device__ __forceinline__ void operator()(const f32x4 (&acc)[2][2][4][2], const Unit& u, int wr, int wc, int fr, int fq) const {
        float* base = O + (size_t)u.g * sO + (size_t)(u.pm * BM + wr * 64 + fr) * ldc + u.pn * BM + wc * 32 + 4 * fq;
#pragma unroll
        for (int ai = 0; ai < 2; ++ai)
#pragma unroll
            for (int m = 0; m < 4; ++m)
#pragma unroll
                for (int bj = 0; bj < 2; ++bj)
#pragma unroll
                    for (int n = 0; n < 2; ++n) *(f32x4*)(base + (size_t)(ai * HALF + m * 16) * ldc + bj * HALF + n * 16) = acc[ai][bj][m][n];
    }
};
struct EpiScan {
    static constexpr bool PERM = false, AFTER_DRAIN = true; static constexpr int MID_T = -1;
    bf16_t* Acat; const float* lam1; const float* lam32; const float* BbW; const float* umeta;
    __device__ __forceinline__ unsigned short bfr(float f) const { unsigned u = __builtin_bit_cast(unsigned, f); return (unsigned short)((u + 0x7fffu + ((u >> 16) & 1u)) >> 16); }
    __device__ __forceinline__ void fused(f32x4 (&acc)[2][2][4][2], const Unit& u, int wr, int wc, int fr, int fq, PG8_LAS unsigned char* lds, int wid, int lane) const {
        constexpr int LS = 132;
        PG8_LAS float* Sl = (PG8_LAS float*)lds;
        PG8_LAS float* E = Sl + 256 * LS;
        PG8_LAS float* xm = E + 512;
        const int tid = wid * 64 + lane, g = u.g, b = u.pm, n = tid & 63, seg = (tid >> 6) & 3;
#pragma unroll
        for (int d = 0; d < 2; ++d) {
#pragma unroll
            for (int ai = 0; ai < 2; ++ai)
#pragma unroll
                for (int m = 0; m < 4; ++m)
#pragma unroll
                    for (int nn = 0; nn < 2; ++nn) *(PG8_LAS f32x4*)(Sl + (ai * HALF + wr * 64 + m * 16 + fr) * LS + wc * 32 + nn * 16 + 4 * fq) = acc[ai][d][m][nn];
            if (d == 0 && tid >= 256 && tid < 320) {
                const float l1r = lam1[((g * 2) * 64 + n) * 2], l1i = lam1[((g * 2) * 64 + n) * 2 + 1];
                const float* bb = BbW + ((size_t)(g * 2) * 64 + n) * 32;
                float mr = 0.f, mi = 0.f;
                for (int s = 0; s < NMETA; ++s) { float br = 0.f, bi = 0.f;
#pragma unroll
                    for (int p = 0; p < GP; ++p) { const float uu = umeta[s * SSMW + g * GP + p]; br += bb[2 * p] * uu; bi += bb[2 * p + 1] * uu; }
                    const float nr = l1r * mr - l1i * mi + br, ni = l1r * mi + l1i * mr + bi; mr = nr; mi = ni; }
                xm[2 * n] = mr; xm[2 * n + 1] = mi;
            }
            asm volatile("s_waitcnt lgkmcnt(0)" ::: "memory"); __builtin_amdgcn_s_barrier(); asm volatile("" ::: "memory");
            const float l32r = lam32[((g * 2 + d) * 64 + n) * 2], l32i = lam32[((g * 2 + d) * 64 + n) * 2 + 1];
            float xr = 0.f, xi = 0.f;
            if (tid < 256) {
                for (int j0 = 0; j0 < 64; j0 += 16) { float sr[16], si[16];
#pragma unroll
                    for (int e = 0; e < 16; ++e) { const int c = seg * 64 + (d ? 63 - j0 - e : j0 + e); sr[e] = Sl[c * LS + n]; si[e] = Sl[c * LS + 64 + n]; }
#pragma unroll
                    for (int e = 0; e < 16; ++e) { const float nr = l32r * xr - l32i * xi + sr[e], ni = l32r * xi + l32i * xr + si[e]; xr = nr; xi = ni; } }
                E[(seg * 64 + n) * 2] = xr; E[(seg * 64 + n) * 2 + 1] = xi;
            }
            asm volatile("s_waitcnt lgkmcnt(0)" ::: "memory"); __builtin_amdgcn_s_barrier(); asm volatile("" ::: "memory");
            if (tid < 256) {
                float pr = l32r, pi_ = l32i;
#pragma unroll
                for (int q = 0; q < 6; ++q) { const float a = pr * pr - pi_ * pi_, c2 = 2.f * pr * pi_; pr = a; pi_ = c2; }
                if (d == 0) { xr = xm[2 * n]; xi = xm[2 * n + 1];
                    for (int s = 0; s < seg; ++s) { const float er = E[(s * 64 + n) * 2], ei = E[(s * 64 + n) * 2 + 1]; const float nr = pr * xr - pi_ * xi + er, ni = pr * xi + pi_ * xr + ei; xr = nr; xi = ni; }
                } else { xr = 0.f; xi = 0.f;
                    for (int s = 3; s > seg; --s) { const float er = E[(s * 64 + n) * 2], ei = E[(s * 64 + n) * 2 + 1]; const float nr = pr * xr - pi_ * xi + er, ni = pr * xi + pi_ * xr + ei; xr = nr; xi = ni; } }
                for (int j0 = 0; j0 < 64; j0 += 16) { float sr[16], si[16];
#pragma unroll
                    for (int e = 0; e < 16; ++e) { const int cl = d ? 63 - j0 - e : j0 + e; sr[e] = Sl[(seg * 64 + cl) * LS + n]; si[e] = Sl[(seg * 64 + cl) * LS + 64 + n]; }
#pragma unroll
                    for (int e = 0; e < 16; ++e) { const int cl = d ? 63 - j0 - e : j0 + e;
                        Sl[(seg * 64 + cl) * LS + n] = xr; Sl[(seg * 64 + cl) * LS + 64 + n] = xi;
                        const float nr = l32r * xr - l32i * xi + sr[e], ni = l32r * xi + l32i * xr + si[e]; xr = nr; xi = ni; } }
            }
            asm volatile("s_waitcnt lgkmcnt(0)" ::: "memory"); __builtin_amdgcn_s_barrier(); asm volatile("" ::: "memory");
#pragma unroll
            for (int q = 0; q < 8; ++q) { const int piece = tid + 512 * q, row = piece >> 4, c8 = (piece & 15) * 8;
                const f32x4 a = *(const PG8_LAS f32x4*)(Sl + row * LS + c8), c = *(const PG8_LAS f32x4*)(Sl + row * LS + c8 + 4);
                *(u32x4*)(Acat + ((size_t)g * CROWS + b * NCH + row) * KCAT + 512 + d * 128 + c8) = pack8(a, c); }
            asm volatile("s_waitcnt lgkmcnt(0)" ::: "memory"); __builtin_amdgcn_s_barrier(); asm volatile("" ::: "memory");
        }
    }
};
struct EpiSsmC {
    static constexpr bool PERM = true, AFTER_DRAIN = false; static constexpr int MID_T = -1;
    bf16_t* Z;
    __device__ __forceinline__ void operator()(const f32x4 (&acc)[2][2][4][2], const Unit& u, int wr, int wc, int fr, int fq) const {
#pragma unroll
        for (int ai = 0; ai < 2; ++ai)
#pragma unroll
            for (int m = 0; m < 4; ++m) { const int R = u.pm * BM + wr * 64 + fr + ai * HALF + m * 16;
#pragma unroll
                for (int bj = 0; bj < 2; ++bj) { const int c = u.pn * BM + bj * HALF + wc * 32 + 8 * fq, i = c >> 4, p0 = c & 15;
                    const f32x4 v0 = acc[ai][bj][m][0], v1 = acc[ai][bj][m][1];
                    const f32x2 a = gelu_pk((f32x2){v0[0], v0[1]}), b = gelu_pk((f32x2){v0[2], v0[3]}), cc = gelu_pk((f32x2){v1[0], v1[1]}), dd = gelu_pk((f32x2){v1[2], v1[3]});
                    u32x4 w; w.x = cvt_pk_bf16(a.x, a.y); w.y = cvt_pk_bf16(b.x, b.y); w.z = cvt_pk_bf16(cc.x, cc.y); w.w = cvt_pk_bf16(dd.x, dd.y);
                    *(u32x4*)(Z + ((size_t)R * CT + i) * SSMW + u.g * GP + p0) = w; } }
    }
};
template <int MODE> struct EpiEw {
    static constexpr bool PERM = true, AFTER_DRAIN = false; static constexpr int MID_T = -1;
    bf16_t* O; int ldc; const bf16_t* In0; int ld0, off0; const bf16_t* In1; int ld1; const float* vec;
    __device__ __forceinline__ void operator()(const f32x4 (&acc)[2][2][4][2], const Unit& u, int wr, int wc, int fr, int fq) const {
        const int rowb = u.pm * BM + wr * 64 + fr, colb = u.pn * BM + wc * 32 + 8 * fq;
        f32x4 bv[2][2];
        if (MODE == 0) {
#pragma unroll
            for (int bj = 0; bj < 2; ++bj)
#pragma unroll
                for (int n = 0; n < 2; ++n) bv[bj][n] = *(const f32x4*)(vec + colb + bj * HALF + 4 * n);
        }
        u32x4 pre[2][4][2]; float rinv[2][4];
#pragma unroll
        for (int ai = 0; ai < 2; ++ai)
#pragma unroll
            for (int m = 0; m < 4; ++m) { const int row = rowb + ai * HALF + m * 16;
                rinv[ai][m] = 1.f; if (MODE == 5) rinv[ai][m] = vec[row];
                if (MODE == 0 || MODE == 1 || MODE == 2) {
#pragma unroll
                    for (int bj = 0; bj < 2; ++bj) pre[ai][m][bj] = *(const u32x4*)(In0 + (size_t)row * ld0 + off0 + colb + bj * HALF); } }
        asm volatile("" ::: "memory");
#pragma unroll
        for (int ai = 0; ai < 2; ++ai)
#pragma unroll
            for (int m = 0; m < 4; ++m) { const int row = rowb + ai * HALF + m * 16;
                float ri = 1.f; if (MODE == 5) ri = __builtin_amdgcn_rsqf(rinv[ai][m] * (1.0f / 1024.0f) + NORM_EPS);
#pragma unroll
                for (int bj = 0; bj < 2; ++bj) { const int col = colb + bj * HALF;
                    f32x4 v0 = acc[ai][bj][m][0], v1 = acc[ai][bj][m][1];
                    if (MODE == 0) { const u32x4 z = pre[ai][m][bj]; v0 += bv[bj][0]; v1 += bv[bj][1];
                        v0[0] = bf_lo(z.x) * sigmoidf_(v0[0]); v0[1] = bf_hi(z.x) * sigmoidf_(v0[1]); v0[2] = bf_lo(z.y) * sigmoidf_(v0[2]); v0[3] = bf_hi(z.y) * sigmoidf_(v0[3]);
                        v1[0] = bf_lo(z.z) * sigmoidf_(v1[0]); v1[1] = bf_hi(z.z) * sigmoidf_(v1[1]); v1[2] = bf_lo(z.w) * sigmoidf_(v1[2]); v1[3] = bf_hi(z.w) * sigmoidf_(v1[3]); }
                    if (MODE == 1 || MODE == 2) { const u32x4 g = pre[ai][m][bj];
                        v0[0] *= bf_lo(g.x); v0[1] *= bf_hi(g.x); v0[2] *= bf_lo(g.y); v0[3] *= bf_hi(g.y); v1[0] *= bf_lo(g.z); v1[1] *= bf_hi(g.z); v1[2] *= bf_lo(g.w); v1[3] *= bf_hi(g.w); }
                    if (MODE == 2) { const u32x4 t = *(const u32x4*)(In1 + (size_t)row * ld1 + col);
                        v0[0] += bf_lo(t.x); v0[1] += bf_hi(t.x); v0[2] += bf_lo(t.y); v0[3] += bf_hi(t.y); v1[0] += bf_lo(t.z); v1[1] += bf_hi(t.z); v1[2] += bf_lo(t.w); v1[3] += bf_hi(t.w); }
                    if (MODE == 5) {
#pragma unroll
                        for (int e = 0; e < 4; ++e) { float a = fmaxf(v0[e] * ri, 0.f), c = fmaxf(v1[e] * ri, 0.f); v0[e] = a * a; v1[e] = c * c; } }
                    *(u32x4*)(O + (size_t)row * ldc + col) = pack8(v0, v1); } }
    }
};
struct EpiRes {
    static constexpr bool PERM = true, AFTER_DRAIN = false; static constexpr int MID_T = -1;
    bf16_t* Hb; const float* rowscale; float* rss;
    __device__ __forceinline__ void operator()(const f32x4 (&acc)[2][2][4][2], const Unit& u, int wr, int wc, int fr, int fq) const {
        const int rowb = u.pm * BM + wr * 64 + fr, colb = u.pn * BM + wc * 32 + 8 * fq;
        u32x4 pre[2][4][2]; float rsv[2][4];
#pragma unroll
        for (int ai = 0; ai < 2; ++ai)
#pragma unroll
            for (int m = 0; m < 4; ++m) { const int row = rowb + ai * HALF + m * 16; rsv[ai][m] = rowscale ? rowscale[row] : 1.0f;
#pragma unroll
                for (int bj = 0; bj < 2; ++bj) pre[ai][m][bj] = *(const u32x4*)(Hb + (size_t)row * D + colb + bj * HALF); }
        asm volatile("" ::: "memory");
#pragma unroll
        for (int ai = 0; ai < 2; ++ai)
#pragma unroll
            for (int m = 0; m < 4; ++m) { const int row = rowb + ai * HALF + m * 16; float ss = 0.f; const float rs = rsv[ai][m];
#pragma unroll
                for (int bj = 0; bj < 2; ++bj) { const size_t off = (size_t)row * D + colb + bj * HALF;
                    const u32x4 t = pre[ai][m][bj];
                    f32x4 h0, h1;
                    h0[0] = bf_lo(t.x); h0[1] = bf_hi(t.x); h0[2] = bf_lo(t.y); h0[3] = bf_hi(t.y); h1[0] = bf_lo(t.z); h1[1] = bf_hi(t.z); h1[2] = bf_lo(t.w); h1[3] = bf_hi(t.w);
                    h0 = h0 * rs + acc[ai][bj][m][0]; h1 = h1 * rs + acc[ai][bj][m][1];
                    *(u32x4*)(Hb + off) = pack8(h0, h1);
                    ss += (h0[0] * h0[0] + h0[1] * h0[1]) + (h0[2] * h0[2] + h0[3] * h0[3]) + (h1[0] * h1[0] + h1[1] * h1[1]) + (h1[2] * h1[2] + h1[3] * h1[3]); }
                ss += __shfl_xor(ss, 16); ss += __shfl_xor(ss, 32);
                if (fq == 0) atomicAdd(rss + row, ss); }
    }
};
struct EpiGate {
    static constexpr bool PERM = true, AFTER_DRAIN = false; static constexpr int MID_T = 8;
    bf16_t* O; const bf16_t* Gt;
    __device__ __forceinline__ void mid(f32x4 (&acc)[2][2][4][2], const Unit& u, int wr, int wc, int fr, int fq) const {
        int rowb = u.pm * BM + wr * 64 + fr, colb = u.pn * BM + wc * 32 + 8 * fq;
        asm volatile("" : "+v"(rowb), "+v"(colb));
#pragma unroll
        for (int ai = 0; ai < 2; ++ai) {
            u32x4 ga[4][2], gb[4][2];
#pragma unroll
            for (int m = 0; m < 4; ++m)
#pragma unroll
                for (int bj = 0; bj < 2; ++bj) { const bf16_t* gp = Gt + (size_t)(rowb + ai * HALF + m * 16) * 2048 + colb + bj * HALF; ga[m][bj] = *(const u32x4*)gp; gb[m][bj] = *(const u32x4*)(gp + 1024); }
#pragma unroll
            for (int m = 0; m < 4; ++m)
#pragma unroll
                for (int bj = 0; bj < 2; ++bj) { const u32x4 a = ga[m][bj], b = gb[m][bj];
                    f32x4 r0, r1;
                    r0[0] = bf_lo(a.x) * __builtin_amdgcn_rcpf(fmaxf(bf_lo(b.x), 1e-30f)); r0[1] = bf_hi(a.x) * __builtin_amdgcn_rcpf(fmaxf(bf_hi(b.x), 1e-30f));
                    r0[2] = bf_lo(a.y) * __builtin_amdgcn_rcpf(fmaxf(bf_lo(b.y), 1e-30f)); r0[3] = bf_hi(a.y) * __builtin_amdgcn_rcpf(fmaxf(bf_hi(b.y), 1e-30f));
                    r1[0] = bf_lo(a.z) * __builtin_amdgcn_rcpf(fmaxf(bf_lo(b.z), 1e-30f)); r1[1] = bf_hi(a.z) * __builtin_amdgcn_rcpf(fmaxf(bf_hi(b.z), 1e-30f));
                    r1[2] = bf_lo(a.w) * __builtin_amdgcn_rcpf(fmaxf(bf_lo(b.w), 1e-30f)); r1[3] = bf_hi(a.w) * __builtin_amdgcn_rcpf(fmaxf(bf_hi(b.w), 1e-30f));
                    acc[ai][bj][m][0] *= r0; acc[ai][bj][m][1] *= r1; }
            asm volatile("" ::: "memory"); }
    }
    __device__ __forceinline__ void operator()(const f32x4 (&acc)[2][2][4][2], const Unit& u, int wr, int wc, int fr, int fq) const {
        const int rowb = u.pm * BM + wr * 64 + fr, colb = u.pn * BM + wc * 32 + 8 * fq;
        u32x4 pre[2][4][2];
#pragma unroll
        for (int ai = 0; ai < 2; ++ai)
#pragma unroll
            for (int m = 0; m < 4; ++m)
#pragma unroll
                for (int bj = 0; bj < 2; ++bj) pre[ai][m][bj] = *(const u32x4*)(Gt + (size_t)(rowb + ai * HALF + m * 16) * 2048 + 1024 + colb + bj * HALF);
        asm volatile("" ::: "memory");
#pragma unroll
        for (int ai = 0; ai < 2; ++ai)
#pragma unroll
            for (int m = 0; m < 4; ++m) { const int row = rowb + ai * HALF + m * 16;
#pragma unroll
                for (int bj = 0; bj < 2; ++bj) { const int col = colb + bj * HALF;
                    const u32x4 g = pre[ai][m][bj];
                    f32x4 v0 = acc[ai][bj][m][0], v1 = acc[ai][bj][m][1];
                    v0[0] *= bf_lo(g.x); v0[1] *= bf_hi(g.x); v0[2] *= bf_lo(g.y); v0[3] *= bf_hi(g.y); v1[0] *= bf_lo(g.z); v1[1] *= bf_hi(g.z); v1[2] *= bf_lo(g.w); v1[3] *= bf_hi(g.w);
                    *(u32x4*)(O + (size_t)row * D + col) = pack8(v0, v1); } }
    }
};
template <class Epi, class Sched, bool ALIGN_EPI = false, bool SP2 = false>
__device__ __forceinline__ void gemm_phase(PG8_LAS unsigned char* lds, const Gemm g, const Sched& S, const Epi& E) {
    int tid_ = threadIdx.x; asm volatile("" : "+v"(tid_));
    const int tid = tid_, wid = __builtin_amdgcn_readfirstlane(tid >> 6), lane = tid & 63, wr = wid >> 2, wc = wid & 3, fr = lane & 15, fq = lane >> 4;
    const int K = g.K, nt = K / BK;
    unsigned voffA[2], voffB[2];
#pragma unroll
    for (int i = 0; i < 2; ++i) { int R, C; stage_rc(tid * 16 + i * 8192, R, C); const int Rb = Epi::PERM ? ((R & ~31) + perm32(R & 31)) : R;
        voffA[i] = (unsigned)(R * g.lda + C) * 2u; voffB[i] = (unsigned)(Rb * g.ldb + C) * 2u; }
    const size_t kstep = (size_t)(BK * 2);
    const size_t hstepA = (size_t)HALF * g.lda * 2, hstepB = (size_t)HALF * g.ldb * 2;
    const size_t tstepA = 2 * hstepA, tstepB = 2 * hstepB;
    const unsigned ldsw = (unsigned)wid * 1024u;
    const int aoff = lds_byte(wr * 64 + fr, fq * 8), boff = lds_byte(wc * 32 + fr, fq * 8);
#define PG8_SA(b, h) (((b) * 2 + (h)) * HTB)
#define PG8_SB(b, h) ((4 + (b) * 2 + (h)) * HTB)
#define PG8_STAGE(bufoff, gbase, voff) do { _Pragma("unroll") for (int _i = 0; _i < 2; ++_i) \
        __builtin_amdgcn_global_load_lds((const unsigned*)((const char*)(gbase) + (voff)[_i]), (PG8_LAS unsigned*)(lds + (bufoff) + ldsw + _i * 8192), 16, 0, 0); } while (0)
#define PG8_LDA(dst, b, h) do { _Pragma("unroll") for (int m = 0; m < 4; ++m) _Pragma("unroll") for (int k = 0; k < 2; ++k) dst[m][k] = *(const PG8_LAS bf16x8*)(lds + PG8_SA(b, h) + aoff + m * 2048 + k * 1024); } while (0)
#define PG8_LDB(dst, b, h) do { _Pragma("unroll") for (int n = 0; n < 2; ++n) _Pragma("unroll") for (int k = 0; k < 2; ++k) dst[n][k] = *(const PG8_LAS bf16x8*)(lds + PG8_SB(b, h) + boff + n * 2048 + k * 1024); } while (0)
#define PG8_MMA(ai, bj, At, Bt) do { __builtin_amdgcn_s_setprio(1); _Pragma("unroll") for (int m = 0; m < 4; ++m) _Pragma("unroll") for (int n = 0; n < 2; ++n) _Pragma("unroll") for (int k = 0; k < 2; ++k) \
        acc[ai][bj][m][n] = __builtin_amdgcn_mfma_f32_16x16x32_bf16(Bt[n][k], At[m][k], acc[ai][bj][m][n], 0, 0, 0); __builtin_amdgcn_s_setprio(0); } while (0)
#define PG8_WAIT_V(n) asm volatile("s_waitcnt vmcnt(" #n ")" ::: "memory")
#define PG8_WAIT_L(n) asm volatile("s_waitcnt lgkmcnt(" #n ")" ::: "memory")
#define PG8_BAR __builtin_amdgcn_s_barrier()
#define PG8_SCHED __builtin_amdgcn_sched_barrier(0)
    Unit cur, nxt; int ui = 0;
    if (!S.next(0, cur)) return;
    f32x4 acc[2][2][4][2];
#pragma unroll
    for (int a = 0; a < 2; ++a)
#pragma unroll
        for (int b = 0; b < 2; ++b)
#pragma unroll
            for (int m = 0; m < 4; ++m)
#pragma unroll
                for (int n = 0; n < 2; ++n) acc[a][b][m][n] = (f32x4){0.f, 0.f, 0.f, 0.f};
    bf16x8 At[4][2], B0[2][2], B1[2][2];
    const char* cA = (const char*)g.A + (size_t)cur.g * g.sA * 2 + (size_t)cur.pm * tstepA; const char* cB = (const char*)g.Bt + (size_t)cur.g * g.sB * 2 + (size_t)cur.pn * tstepB;
    if constexpr (SP2) {
        PG8_STAGE(PG8_SB(0, 0), cB, voffB); PG8_STAGE(PG8_SB(0, 1), cB + hstepB, voffB); PG8_STAGE(PG8_SA(0, 0), cA, voffA); PG8_STAGE(PG8_SA(0, 1), cA + hstepA, voffA);
        if (wr == 1) PG8_BAR;
        PG8_WAIT_V(2); PG8_BAR;
        PG8_STAGE(PG8_SB(1, 0), cB + kstep, voffB); PG8_STAGE(PG8_SA(1, 0), cA + kstep, voffA); PG8_STAGE(PG8_SB(1, 1), cB + hstepB + kstep, voffB);
        PG8_WAIT_V(6); PG8_BAR;
    } else {
        PG8_STAGE(PG8_SB(0, 0), cB, voffB); PG8_STAGE(PG8_SA(0, 0), cA, voffA); PG8_STAGE(PG8_SB(0, 1), cB + hstepB, voffB); PG8_STAGE(PG8_SA(0, 1), cA + hstepA, voffA);
        if (wr == 1) PG8_BAR;
        PG8_WAIT_V(4); PG8_BAR;
        PG8_STAGE(PG8_SB(1, 0), cB + kstep, voffB); PG8_STAGE(PG8_SA(1, 0), cA + kstep, voffA); PG8_STAGE(PG8_SB(1, 1), cB + hstepB + kstep, voffB);
        PG8_WAIT_V(6); PG8_BAR;
    }
    for (;;) {
        const bool has_next = S.next(ui + 1, nxt);
        const char* nA = has_next ? (const char*)g.A + (size_t)nxt.g * g.sA * 2 + (size_t)nxt.pm * tstepA : cA; const char* nB = has_next ? (const char*)g.Bt + (size_t)nxt.g * g.sB * 2 + (size_t)nxt.pn * tstepB : cB;
        for (int t = 0; t < nt; t += 2) {
            const bool last = (t == nt - 2);
            const char* a1 = cA + (size_t)(t + 1) * kstep;
            const char* a2 = last ? nA : cA + (size_t)(t + 2) * kstep; const char* b2 = last ? nB : cB + (size_t)(t + 2) * kstep;
            const char* a3 = a2 + kstep; const char* b3 = b2 + kstep;
            if constexpr (Epi::MID_T >= 0) { if (t == Epi::MID_T) E.mid(acc, cur, wr, wc, fr, fq); }
            if constexpr (SP2) {
            PG8_LDB(B0, 0, 0); PG8_LDB(B1, 0, 1); PG8_SCHED; PG8_LDA(At, 0, 0); PG8_STAGE(PG8_SA(1, 1), a1 + hstepA, voffA);
            PG8_WAIT_V(8); PG8_WAIT_L(0); PG8_BAR; PG8_MMA(0, 0, At, B0); PG8_MMA(0, 1, At, B1); PG8_BAR; PG8_SCHED;
            PG8_LDA(At, 0, 1); PG8_STAGE(PG8_SB(0, 0), b2, voffB); PG8_STAGE(PG8_SB(0, 1), b2 + hstepB, voffB); PG8_STAGE(PG8_SA(0, 0), a2, voffA);
            PG8_WAIT_V(8); PG8_WAIT_L(0); PG8_BAR; PG8_MMA(1, 0, At, B0); PG8_MMA(1, 1, At, B1); PG8_BAR; PG8_SCHED;
            PG8_LDB(B0, 1, 0); PG8_LDB(B1, 1, 1); PG8_SCHED; PG8_LDA(At, 1, 0); PG8_STAGE(PG8_SA(0, 1), a2 + hstepA, voffA);
            PG8_WAIT_V(8); PG8_WAIT_L(0); PG8_BAR; PG8_MMA(0, 0, At, B0); PG8_MMA(0, 1, At, B1); PG8_BAR; PG8_SCHED;
            PG8_LDA(At, 1, 1); PG8_STAGE(PG8_SB(1, 0), b3, voffB); PG8_STAGE(PG8_SB(1, 1), b3 + hstepB, voffB); PG8_STAGE(PG8_SA(1, 0), a3, voffA);
            PG8_WAIT_V(8); PG8_WAIT_L(0); PG8_BAR; PG8_MMA(1, 0, At, B0); PG8_MMA(1, 1, At, B1); PG8_BAR; PG8_SCHED;
            } else {
            PG8_LDB(B0, 0, 0); PG8_SCHED; PG8_LDA(At, 0, 0); PG8_STAGE(PG8_SA(1, 1), a1 + hstepA, voffA);
            PG8_WAIT_L(8); PG8_BAR; PG8_WAIT_L(0); PG8_MMA(0, 0, At, B0); PG8_BAR; PG8_SCHED;
            PG8_LDB(B1, 0, 1); PG8_STAGE(PG8_SB(0, 0), b2, voffB);
            PG8_BAR; PG8_WAIT_L(0); PG8_MMA(0, 1, At, B1); PG8_BAR;
            PG8_LDA(At, 0, 1); PG8_STAGE(PG8_SA(0, 0), a2, voffA);
            PG8_BAR; PG8_WAIT_L(0); PG8_MMA(1, 0, At, B0); PG8_BAR; PG8_SCHED;
            PG8_STAGE(PG8_SB(0, 1), b2 + hstepB, voffB);
            PG8_WAIT_V(6); PG8_BAR; PG8_MMA(1, 1, At, B1); PG8_BAR;
            PG8_LDB(B0, 1, 0); PG8_SCHED; PG8_LDA(At, 1, 0); PG8_STAGE(PG8_SA(0, 1), a2 + hstepA, voffA);
            PG8_WAIT_L(8); PG8_BAR; PG8_WAIT_L(0); PG8_MMA(0, 0, At, B0); PG8_BAR; PG8_SCHED;
            PG8_LDB(B1, 1, 1); PG8_STAGE(PG8_SB(1, 0), b3, voffB);
            PG8_BAR; PG8_WAIT_L(0); PG8_MMA(0, 1, At, B1); PG8_BAR;
            PG8_LDA(At, 1, 1); PG8_STAGE(PG8_SA(1, 0), a3, voffA);
            PG8_BAR; PG8_WAIT_L(0); PG8_MMA(1, 0, At, B0); PG8_BAR; PG8_SCHED;
            PG8_STAGE(PG8_SB(1, 1), b3 + hstepB, voffB);
            PG8_WAIT_V(6); PG8_BAR; PG8_MMA(1, 1, At, B1); PG8_BAR;
            }
        }
        if constexpr (ALIGN_EPI) { if (wr == 0) PG8_BAR; }
        if constexpr (!Epi::AFTER_DRAIN) { E(acc, cur, wr, wc, fr, fq); }
        if (!has_next) break;
#pragma unroll
        for (int a = 0; a < 2; ++a)
#pragma unroll
            for (int b = 0; b < 2; ++b)
#pragma unroll
                for (int m = 0; m < 4; ++m)
#pragma unroll
                    for (int n = 0; n < 2; ++n) acc[a][b][m][n] = (f32x4){0.f, 0.f, 0.f, 0.f};
        cur = nxt; cA = nA; cB = nB; ++ui;
        if constexpr (ALIGN_EPI) { if (wr == 1) PG8_BAR; }
    }
    PG8_WAIT_V(0);
    if constexpr (!ALIGN_EPI) { if (wr == 0) PG8_BAR; }
    PG8_BAR;
    if constexpr (Epi::AFTER_DRAIN) { E.fused(acc, cur, wr, wc, fr, fq, lds, wid, lane); }
#undef PG8_SA
#undef PG8_SB
#undef PG8_STAGE
#undef PG8_LDA
#undef PG8_LDB
#undef PG8_MMA
#undef PG8_WAIT_V
#undef PG8_WAIT_L
#undef PG8_BAR
#undef PG8_SCHED
}
}
namespace attn_body {
using bf16=__hip_bfloat16;
using bf16x8=__attribute__((ext_vector_type(8)))short;
using s16x4=__attribute__((ext_vector_type(4)))short;
using f32x16=__attribute__((ext_vector_type(16)))float;
using u32x4=__attribute__((ext_vector_type(4)))unsigned;
constexpr int BATCH=8,NHEAD=16,SEQ=8192,D=64,DM=1536;
constexpr int KVP=256,KVROWS=SEQ+64,NTILES=KVROWS/64;
constexpr int NW=8,QBLK=32,QB=QBLK*NW,KVBLK=64,NQB=SEQ/QB;
constexpr int ATTN_PITCH=DM, ATTN_UNIT_ROWS=QB;
__device__ __forceinline__ int crow(int r,int hi){return (r&3)+8*(r>>2)+4*hi;}
#define SBAR() __builtin_amdgcn_sched_barrier(0)
constexpr int NSLOT=3, SLOTB=8192;
constexpr int LDS_K=0, LDS_V=NSLOT*SLOTB, LDS_WS=2*NSLOT*SLOTB, LDS_OST=LDS_WS+NW*64*4, LDS_BYTES=LDS_OST+NW*4096;
constexpr float C2=0.125f*1.4426950408889634f;
__device__ __forceinline__ void glds16(const void*gsrc,unsigned lds_dst){unsigned keep;
  asm volatile("s_mov_b32 %0, m0\n\ts_mov_b32 m0, %2\n\ts_nop 0\n\tglobal_load_lds_dwordx4 %1, off\n\ts_mov_b32 m0, %0":"=&s"(keep):"v"(gsrc),"s"(lds_dst):"memory");}
__device__ __forceinline__ float max3f(float a,float b,float c){float r;asm("v_max3_f32 %0, %1, %2, %3":"=v"(r):"v"(a),"v"(b),"v"(c));return r;}
__device__ __forceinline__ float max2f(float a,float b){float r;asm("v_max_f32_e32 %0, %1, %2":"=v"(r):"v"(a),"v"(b));return r;}
__device__ __forceinline__ float fadd_s(float a,float b){float r;asm("v_add_f32_e32 %0, %1, %2":"=v"(r):"v"(a),"v"(b));return r;}
__device__ __forceinline__ float fsub_s(float a,float b){float r;asm("v_sub_f32_e32 %0, %1, %2":"=v"(r):"v"(a),"v"(b));return r;}
typedef float f32x2_t __attribute__((ext_vector_type(2))); typedef __bf16 bf16x2_t __attribute__((ext_vector_type(2)));
__device__ __forceinline__ unsigned cvtpk_s(float lo,float hi){f32x2_t v={lo,hi};bf16x2_t b=__builtin_convertvector(v,bf16x2_t);return __builtin_bit_cast(unsigned,b);}
#define WAIT_BAR(N) asm volatile("s_waitcnt vmcnt(" #N ") lgkmcnt(0)\n\ts_barrier":::"memory")

__device__ __forceinline__ void qkt(f32x16&p0,f32x16&p1,const char*Kslot,const bf16x8*qr,const f32x16&negm,int r32,int hi){
  const char*kb=Kslot+hi*1024+r32*16;
  #pragma unroll
  for(int d0=0;d0<4;++d0){
    const bf16x8 b0=*reinterpret_cast<const bf16x8*>(kb+d0*2048);
    const bf16x8 b1=*reinterpret_cast<const bf16x8*>(kb+d0*2048+512);
    if(d0==0){p0=__builtin_amdgcn_mfma_f32_32x32x16_bf16(b0,qr[0],negm,0,0,0);p1=__builtin_amdgcn_mfma_f32_32x32x16_bf16(b1,qr[0],negm,0,0,0);}
    else{p0=__builtin_amdgcn_mfma_f32_32x32x16_bf16(b0,qr[d0],p0,0,0,0);p1=__builtin_amdgcn_mfma_f32_32x32x16_bf16(b1,qr[d0],p1,0,0,0);}}
}
typedef __attribute__((address_space(3))) const char* lds_cptr;
typedef short v4i16_t __attribute__((ext_vector_type(4)));
__device__ __forceinline__ void kload8(bf16x8*kf,lds_cptr kp){
  kf[0]=*(const __attribute__((address_space(3))) bf16x8*)(kp);      kf[1]=*(const __attribute__((address_space(3))) bf16x8*)(kp+512);
  kf[2]=*(const __attribute__((address_space(3))) bf16x8*)(kp+2048); kf[3]=*(const __attribute__((address_space(3))) bf16x8*)(kp+2560);
  kf[4]=*(const __attribute__((address_space(3))) bf16x8*)(kp+4096); kf[5]=*(const __attribute__((address_space(3))) bf16x8*)(kp+4608);
  kf[6]=*(const __attribute__((address_space(3))) bf16x8*)(kp+6144); kf[7]=*(const __attribute__((address_space(3))) bf16x8*)(kp+6656);
}
__device__ __forceinline__ void kload2(bf16x8*kf,lds_cptr kp,int j){ kf[2*j]=*(const __attribute__((address_space(3))) bf16x8*)(kp+j*2048); kf[2*j+1]=*(const __attribute__((address_space(3))) bf16x8*)(kp+j*2048+512); }
__device__ __forceinline__ s16x4 vtr(lds_cptr p){ return __builtin_bit_cast(s16x4,__builtin_amdgcn_ds_read_tr16_b64_v4i16((__attribute__((address_space(3))) v4i16_t*)p)); }
__device__ __forceinline__ float rowmax(const f32x16&p0,const f32x16&p1){
  float a=max3f(p0[0],p0[1],p1[0]),b=max3f(p0[2],p0[3],p1[1]);a=max3f(a,p1[2],p1[3]);
  #pragma unroll
  for(int r=4;r<16;r+=4){a=max3f(a,p0[r],p0[r+1]);b=max3f(b,p0[r+2],p0[r+3]);a=max3f(a,p1[r],p1[r+1]);b=max3f(b,p1[r+2],p1[r+3]);}
  const float m=max2f(a,b);
  auto rr=__builtin_amdgcn_permlane32_swap(__float_as_uint(m),__float_as_uint(m),false,false);
  return max2f(__uint_as_float(rr[0]),__uint_as_float(rr[1]));
}
__device__ __forceinline__ void pv(f32x16*o,int vb,bf16x8 pa0,bf16x8 pa1,bf16x8 pa2,bf16x8 pa3){
  #pragma unroll
  for(int d0=0;d0<2;++d0){s16x4 lo[4],hi[4];
    #pragma unroll
    for(int ks=0;ks<4;++ks){
      asm volatile("ds_read_b64_tr_b16 %0,%1 offset:%c2":"=&v"(lo[ks]):"v"(vb),"i"(d0*4096+ks*1024):"memory");
      asm volatile("ds_read_b64_tr_b16 %0,%1 offset:%c2":"=&v"(hi[ks]):"v"(vb),"i"(d0*4096+ks*1024+512):"memory");}
    asm volatile("s_waitcnt lgkmcnt(0)":::"memory");SBAR();
    #define PK(k) (bf16x8){lo[k][0],lo[k][1],lo[k][2],lo[k][3],hi[k][0],hi[k][1],hi[k][2],hi[k][3]}
    o[d0]=__builtin_amdgcn_mfma_f32_32x32x16_bf16(pa0,PK(0),o[d0],0,0,0);
    o[d0]=__builtin_amdgcn_mfma_f32_32x32x16_bf16(pa1,PK(1),o[d0],0,0,0);
    o[d0]=__builtin_amdgcn_mfma_f32_32x32x16_bf16(pa2,PK(2),o[d0],0,0,0);
    o[d0]=__builtin_amdgcn_mfma_f32_32x32x16_bf16(pa3,PK(3),o[d0],0,0,0);
    #undef PK
  }
}

#ifndef ATTN_STORE16
#define ATTN_STORE16(p,v) (*(u32x4*)(p)=(v))
#endif
template<int THRL> __device__ __forceinline__ void attn_unit(int b,int h,int qb,const bf16*Q,const bf16*__restrict__ K,const bf16*__restrict__ V,bf16*O,char*shm){
  int tid_=threadIdx.x; asm volatile("":"+v"(tid_)); const int tid=tid_,lane=tid&63,r32=lane&31,hi=lane>>5; const int wid=__builtin_amdgcn_readfirstlane(tid>>6);
  const long rowbase=(long)b*SEQ,rowbaseK=(long)b*KVROWS; const int q0=qb*QB,kvh=h>>2;
  const bf16*Qw=Q+(rowbase+q0+wid*QBLK)*DM+h*D;
  const bf16*Kh=K+rowbaseK*KVP+kvh*D,*Vh=V+rowbaseK*KVP+kvh*D;
  const unsigned lds0=(unsigned)(uintptr_t)shm;
  float*wsf=(float*)(shm+LDS_WS)+wid*64;
  const bf16*ksrc=Kh+(long)lane*KVP+wid*8;
  const bf16*vsrc=Vh+(long)(16*(wid&3)+(lane>>2))*KVP+(wid>>2)*32+(lane&3)*8;
  const unsigned kdst=lds0+LDS_K+wid*1024, vdst=lds0+LDS_V+wid*1024;
  #define DMA_K(t,slot) glds16(ksrc+(long)(t)*KVBLK*KVP,(unsigned)__builtin_amdgcn_readfirstlane(kdst+(slot)))
  #define DMA_V(t,slot) glds16(vsrc+(long)(t)*KVBLK*KVP,(unsigned)__builtin_amdgcn_readfirstlane(vdst+(slot)))
  const int vb0=(int)(lds0+LDS_V)+((lane>>4)&1)*32+(lane&3)*8+(4*hi+((lane&15)>>2))*64;
  const char*Kbase=shm+LDS_K; bf16x8 kf[8];
  const lds_cptr shm3=(lds_cptr)shm; const lds_cptr kp0=shm3+LDS_K+hi*1024+r32*16; const lds_cptr vp0=shm3+LDS_V+((lane>>4)&1)*32+(lane&3)*8+(4*hi+((lane&15)>>2))*64;
  constexpr int NT=NTILES;
  DMA_K(0,0);DMA_V(0,0);DMA_K(1,SLOTB);
  bf16x8 qr[4];
  #pragma unroll
  for(int d0=0;d0<4;++d0)qr[d0]=*reinterpret_cast<const bf16x8*>(&Qw[(long)r32*DM+d0*16+hi*8]);
  float l_reg=0.f;f32x16 o[2];o[0]=f32x16{};o[1]=f32x16{};const f32x16 negm=f32x16{};
  #define CMASK(P0,P1,t) do{}while(0)
  #define START(P0,P1) do{ _Pragma("unroll") for(int r=0;r<16;++r)P0[r]=__builtin_amdgcn_exp2f(P0[r]); }while(0)
  #define RESC() do{}while(0)
  f32x16 pA0,pA1,pB0,pB1;
  int sl_prev=0,sl_cur=0,sl_next=SLOTB;
  #define ROT() do{sl_prev=sl_cur;sl_cur=sl_next;sl_next=(sl_next==(NSLOT-1)*SLOTB)?0:sl_next+SLOTB;}while(0)
  DMA_K(2,2*SLOTB);
  WAIT_BAR(3);
  qkt(pA0,pA1,Kbase,qr,negm,r32,hi);asm volatile("s_nop 15\n\ts_nop 7":"+v"(pA0),"+v"(pA1));CMASK(pA0,pA1,0);
  START(pA0,pA1);
  _Pragma("unroll") for(int r=0;r<16;++r)pA1[r]=__builtin_amdgcn_exp2f(pA1[r]);
  WAIT_BAR(0);
  DMA_K(3,0);DMA_V(1,SLOTB);
  ROT();
  kload8(kf,kp0+sl_cur);
  WAIT_BAR(2);
  s16x4 vlo[8],vhi[8]; u32x4 pw0,pw1,pw2,pw3;
  #define PKW(P,B) cvtpk_s(P[B],P[B+1])
  #define PAF(k) __builtin_bit_cast(bf16x8,pw##k)
  #define VFR(i) (bf16x8){vlo[i][0],vlo[i][1],vlo[i][2],vlo[i][3],vhi[i][0],vhi[i][1],vhi[i][2],vhi[i][3]}
  #define PIN(x) asm volatile("":"+v"(x))
  #define MX3(a,b,c) __builtin_fmaxf(__builtin_fmaxf((a),(b)),(c))
  #define GAPA(MF,A0,A1,A2,A3,W0,W1,PW) do{ MF; sacc+=A0; sacc+=A1; sacc+=A2; sacc+=A3; PIN(sacc); W0; W1; PIN(PW); SBAR(); }while(0)
  #define EX(v) __builtin_amdgcn_exp2f(v)
  #define GAPB(MF,X,B) do{ MF; X[B]=EX(X[B]); X[B+1]=EX(X[B+1]); X[B+2]=EX(X[B+2]); X[B+3]=EX(X[B+3]); PIN(X); SBAR(); }while(0)
  #define VRD(i) do{ vlo[i]=vtr(vp_+(((i)>>2)*4096+((i)&3)*1024)); vhi[i]=vtr(vp_+(((i)>>2)*4096+((i)&3)*1024+512)); }while(0)
  #define KRD(G,j) do{ if(G){ kload2(kf,kp0+sl_next,j); SBAR(); } }while(0)
  #define STEP(C0,C1,P0,P1,t,GK,GV,GL) do{ SBAR(); \
    if(wid<4){ if(GK){DMA_K((t)+3,sl_cur);} if(GV){DMA_V((t)+1,sl_next);} }     \
    const lds_cptr vp_=vp0+sl_prev; \
    VRD(0); SBAR(); float sacc=(P0[0]+P0[1]); \
    GAPA(C0=__builtin_amdgcn_mfma_f32_32x32x16_bf16(kf[0],qr[0],negm,0,0,0), P0[2],P0[3],P0[4],P0[5],     pw0[0]=PKW(P0,0), pw0[1]=PKW(P0,2), pw0); \
    VRD(4); SBAR(); GAPA(C1=__builtin_amdgcn_mfma_f32_32x32x16_bf16(kf[1],qr[0],negm,0,0,0), P0[6],P0[7],P0[8],P0[9],     pw0[2]=PKW(P0,4), pw0[3]=PKW(P0,6), pw0); \
    VRD(1); SBAR(); GAPA(C0=__builtin_amdgcn_mfma_f32_32x32x16_bf16(kf[2],qr[1],C0,0,0,0),   P0[10],P0[11],P0[12],P0[13], pw1[0]=PKW(P0,8), pw1[1]=PKW(P0,10), pw1); \
    VRD(5); SBAR(); GAPA(C1=__builtin_amdgcn_mfma_f32_32x32x16_bf16(kf[3],qr[1],C1,0,0,0),   P0[14],P0[15],P1[0],P1[1],   pw1[2]=PKW(P0,12),pw1[3]=PKW(P0,14), pw1); \
    VRD(2); SBAR(); GAPA(C0=__builtin_amdgcn_mfma_f32_32x32x16_bf16(kf[4],qr[2],C0,0,0,0),   P1[2],P1[3],P1[4],P1[5],     pw2[0]=PKW(P1,0), pw2[1]=PKW(P1,2), pw2); \
    VRD(6); SBAR(); GAPA(C1=__builtin_amdgcn_mfma_f32_32x32x16_bf16(kf[5],qr[2],C1,0,0,0),   P1[6],P1[7],P1[8],P1[9],     pw2[2]=PKW(P1,4), pw2[3]=PKW(P1,6), pw2); \
    VRD(3); SBAR(); GAPA(C0=__builtin_amdgcn_mfma_f32_32x32x16_bf16(kf[6],qr[3],C0,0,0,0),   P1[10],P1[11],P1[12],P1[13], pw3[0]=PKW(P1,8), pw3[1]=PKW(P1,10), pw3); \
    VRD(7); SBAR(); GAPA(C1=__builtin_amdgcn_mfma_f32_32x32x16_bf16(kf[7],qr[3],C1,0,0,0),   P1[14],P1[15],0.f,0.f,       pw3[2]=PKW(P1,12),pw3[3]=PKW(P1,14), pw3); \
    l_reg+=sacc; \
    if(wid>=4){ if(GK){DMA_K((t)+3,sl_cur);} if(GV){DMA_V((t)+1,sl_next);} } \
    CMASK(C0,C1,t); \
    SBAR(); \
    GAPB(o[0]=__builtin_amdgcn_mfma_f32_32x32x16_bf16(PAF(0),VFR(0),o[0],0,0,0), C0,0); \
    GAPB(o[1]=__builtin_amdgcn_mfma_f32_32x32x16_bf16(PAF(0),VFR(4),o[1],0,0,0), C0,4); \
    KRD(GL,0); GAPB(o[0]=__builtin_amdgcn_mfma_f32_32x32x16_bf16(PAF(1),VFR(1),o[0],0,0,0), C0,8); \
    KRD(GL,1); GAPB(o[1]=__builtin_amdgcn_mfma_f32_32x32x16_bf16(PAF(1),VFR(5),o[1],0,0,0), C0,12); \
    KRD(GL,2); GAPB(o[0]=__builtin_amdgcn_mfma_f32_32x32x16_bf16(PAF(2),VFR(2),o[0],0,0,0), C1,0); \
    KRD(GL,3); GAPB(o[1]=__builtin_amdgcn_mfma_f32_32x32x16_bf16(PAF(2),VFR(6),o[1],0,0,0), C1,4); \
    GAPB(o[0]=__builtin_amdgcn_mfma_f32_32x32x16_bf16(PAF(3),VFR(3),o[0],0,0,0), C1,8); \
    GAPB(o[1]=__builtin_amdgcn_mfma_f32_32x32x16_bf16(PAF(3),VFR(7),o[1],0,0,0), C1,12); \
    }while(0)
  int t=1;
  #undef CMASK
  #define CMASK(P0,P1,t) do{}while(0)
  for(;t+5<NT;t+=2){
    STEP(pB0,pB1,pA0,pA1,t,true,true,true);     WAIT_BAR(2); RESC(); ROT();
    STEP(pA0,pA1,pB0,pB1,t+1,true,true,true);   WAIT_BAR(2); RESC(); ROT();
  }
  #undef CMASK
  #define CMASK(P0,P1,t) do{ if((t)==NT-1){ _Pragma("unroll") for(int r_=8;r_<16;++r_)P0[r_]=-INFINITY; _Pragma("unroll") for(int r_=0;r_<16;++r_)P1[r_]=-INFINITY; } }while(0)
  #define ENDW(tt) do{ if((tt)+3<NT){WAIT_BAR(2);} else if((tt)+2<NT){WAIT_BAR(1);} else {WAIT_BAR(0);} }while(0)
  for(;t+1<NT;t+=2){
    STEP(pB0,pB1,pA0,pA1,t,(t+3<NT),(t+1<NT),(t+1<NT));       ENDW(t);   RESC(); ROT();
    STEP(pA0,pA1,pB0,pB1,t+1,(t+4<NT),(t+2<NT),(t+2<NT));     ENDW(t+1); RESC(); ROT();
  }
  static_assert((NT&1)==1&&NT>=7,"odd tile count: the band loop ends on its second step (tile NT-1 in buffer A)");
  { float sacc=pA0[0]+pA0[1]; _Pragma("unroll") for(int r=2;r<16;++r)sacc+=pA0[r]; _Pragma("unroll") for(int r=0;r<16;++r)sacc+=pA1[r]; l_reg+=sacc;
    pw0=(u32x4){PKW(pA0,0),PKW(pA0,2),PKW(pA0,4),PKW(pA0,6)};pw1=(u32x4){PKW(pA0,8),PKW(pA0,10),PKW(pA0,12),PKW(pA0,14)};pw2=(u32x4){PKW(pA1,0),PKW(pA1,2),PKW(pA1,4),PKW(pA1,6)};pw3=(u32x4){PKW(pA1,8),PKW(pA1,10),PKW(pA1,12),PKW(pA1,14)};
    SBAR(); pv(o,vb0+sl_prev,PAF(0),PAF(1),PAF(2),PAF(3)); }
  #undef PKW
  #undef PAF
  #undef VFR
  #undef PIN
  #undef MX3
  #undef GAPA
  #undef GAPB
  #undef EX
  #undef VRD
  #undef KRD
  #undef STEP
  #undef ENDW
  {auto rr=__builtin_amdgcn_permlane32_swap(__float_as_uint(l_reg),__float_as_uint(l_reg),false,false);l_reg=__uint_as_float(rr[0])+__uint_as_float(rr[1]);}
  if(hi==0)wsf[32+r32]=l_reg;asm volatile("s_waitcnt lgkmcnt(0)":::"memory");
  float rli[16];
  #pragma unroll
  for(int r=0;r<16;++r)rli[r]=__builtin_amdgcn_rcpf(wsf[32+crow(r,hi)]);
  bf16*Ow=O+(rowbase+q0+wid*QBLK)*DM+h*D;
  { bf16*stg=(bf16*)(shm+LDS_OST)+wid*2048;
    #pragma unroll
    for(int r=0;r<16;++r){const int orow=crow(r,hi);
      #pragma unroll
      for(int d0=0;d0<2;++d0)stg[orow*64+d0*32+r32]=__float2bfloat16(o[d0][r]*rli[r]);}
    asm volatile("s_waitcnt lgkmcnt(0)":::"memory");
    #pragma unroll
    for(int i=0;i<4;++i){const int row=i*8+(lane>>3),ch=lane&7; const u32x4 v=*(const u32x4*)(stg+row*64+ch*8); ATTN_STORE16(Ow+(long)row*DM+ch*8,v);} }
  asm volatile("s_waitcnt lgkmcnt(0)\n\ts_barrier":::"memory");
  #undef DMA_K
  #undef DMA_V
  #undef CMASK
  #undef START
  #undef RESC
  #undef ROT
}
constexpr int ATTN_LDS_BYTES=LDS_BYTES;
struct AttnTensors { const bf16* Q; const bf16* K; const bf16* V; bf16* O; };
struct AttnUnit { int bh; int qb; };
struct StaticOrder {
  int x,j;
  __device__ __forceinline__ explicit StaticOrder(int grid,int block):x(block&7),j(block>>3){}
  __device__ __forceinline__ bool next(int i,AttnUnit&u)const{ if(i>=16)return false; const int pair=x*4+(i>>2); u.bh=(pair>>2)*NHEAD+(pair&3)*4+(i&3); u.qb=j; return true; }
  __device__ __forceinline__ void a_ready(const AttnUnit&)const{}
  __device__ __forceinline__ void done(const AttnUnit&)const{}
};
template<class Sched,int THRL=8> __device__ __forceinline__ void attn_phase(char*lds,const AttnTensors&T,const Sched&S){
  AttnUnit u;
  for(int i=0;S.next(i,u);++i){ S.a_ready(u); attn_unit<THRL>(u.bh/NHEAD,u.bh%NHEAD,u.qb,T.Q,T.K,T.V,T.O,lds); S.done(u); }
}
#undef SBAR
#undef WAIT_BAR
}
constexpr size_t MiB = 1u << 20, KiB = 1024;
constexpr size_t WS_RSS1 = 0, WS_RSS2 = 256 * KiB, WS_ROPE = 512 * KiB, WS_UMETA = 544 * KiB, WS_LAM1 = 576 * KiB, WS_LAM32 = 608 * KiB, WS_XNRM = 704 * KiB, WS_BBW = 1 * MiB;
constexpr size_t WS_BAR = 640 * KiB;
constexpr size_t WS_WIN = 2 * MiB, WS_WGLU = 10 * MiB, WS_PCAT = 11 * MiB, WS_WOUT = 14 * MiB, WS_W1 = 16 * MiB, WS_W2 = 24 * MiB;
constexpr size_t WS_MCAT = 32 * MiB, WS_MSTATE = 56 * MiB;
constexpr size_t WS_R1 = 64 * MiB;
constexpr size_t WS_ACAT = 192 * MiB, WS_S = 288 * MiB, WS_YQO = 352 * MiB, WS_K = 544 * MiB, WS_V = 577 * MiB, WS_Z = 610 * MiB;
constexpr size_t WS_MERGED = 192 * MiB;
constexpr size_t WS_HID = 192 * MiB;
constexpr size_t WS_GATES = 704 * MiB, WS_END = 960 * MiB;
static_assert(WS_ACAT + (size_t)NGRP * CROWS * KCAT * 2 <= WS_S && WS_S + (size_t)NGRP * CROWS * 256 * 4 <= WS_YQO && WS_YQO + (size_t)M * QP * 2 <= WS_K && WS_K + (size_t)BATCH * KVR * 256 * 2 <= WS_V &&
              WS_V + (size_t)BATCH * KVR * 256 * 2 <= WS_Z && WS_Z + (size_t)M * SSMW * 2 <= WS_GATES && WS_HID + (size_t)M * FF * 2 <= WS_GATES &&
              WS_GATES + (size_t)M * 2048 * 2 <= WS_END && WS_MCAT + (size_t)NGRP * 512 * KCAT * 2 <= WS_MSTATE && WS_MSTATE + (size_t)NGRP * 256 * 512 * 2 <= WS_R1 && WS_R1 + (size_t)M * D * 2 <= WS_ACAT &&
              WS_PCAT + (size_t)D * QP * 2 <= WS_WOUT, "d_ws map");

constexpr int LDS_BYTES = 147456;
#define LAS __attribute__((address_space(3)))
typedef unsigned short bf16;
typedef unsigned v4u __attribute__((ext_vector_type(4)));
typedef unsigned v2u __attribute__((ext_vector_type(2)));
typedef float f32x4 __attribute__((ext_vector_type(4)));
__device__ __forceinline__ unsigned f2bf(float f) { unsigned u = __builtin_bit_cast(unsigned, f); return (u + 0x7fffu + ((u >> 16) & 1u)) >> 16; }
__device__ __forceinline__ unsigned pk2(float lo, float hi) { return f2bf(lo) | (f2bf(hi) << 16); }
__device__ __forceinline__ float wave_sum(float v) {
#pragma unroll
    for (int o = 1; o < 64; o <<= 1) v += __shfl_xor(v, o);
    return v;
}
__device__ __forceinline__ double dexp_(double x) {
    const double y = x * (1.0 / 16.0);
    double p = 1.0 + y * (1.0 + y * (0.5 + y * (1.0 / 6 + y * (1.0 / 24 + y * (1.0 / 120 + y * (1.0 / 720 + y * (1.0 / 5040 + y * (1.0 / 40320 + y * (1.0 / 362880 + y * (1.0 / 3628800 + y * (1.0 / 39916800 + y * (1.0 / 479001600))))))))))));
    p *= p; p *= p; p *= p; p *= p; return p;
}
__device__ __forceinline__ void dsincos_(double a, double& s, double& c) {
    const double q = __builtin_rint(a * 0.63661977236758134308);
    double r = __builtin_fma(-q, 1.57079632679489655800, a); r = __builtin_fma(-q, 6.12323399573676603587e-17, r);
    const double r2 = r * r;
    const double sp = r * (1.0 + r2 * (-1.0 / 6 + r2 * (1.0 / 120 + r2 * (-1.0 / 5040 + r2 * (1.0 / 362880 + r2 * (-1.0 / 39916800 + r2 * (1.0 / 6227020800.0)))))));
    const double cp = 1.0 + r2 * (-0.5 + r2 * (1.0 / 24 + r2 * (-1.0 / 720 + r2 * (1.0 / 40320 + r2 * (-1.0 / 3628800 + r2 * (1.0 / 479001600 + r2 * (-1.0 / 87178291200.0)))))));
    const int qi = ((int)q) & 3;
    s = (qi == 0) ? sp : (qi == 1) ? cp : (qi == 2) ? -sp : -cp;
    c = (qi == 0) ? cp : (qi == 1) ? -sp : (qi == 2) ? -cp : sp;
}

__device__ __forceinline__ void p0_transpose_item(const float* W, int K, int N, bf16* WT, int ldw, int koff, const float* kscale, bool relabel, LAS float* scr, int item, int lane) {
    const int nblk = N / 32, kb = item / nblk, nb = item % nblk, k0 = 64 * kb, n0 = 32 * nb;
#pragma unroll 8
    for (int i = 0; i < 32; ++i) { const int kk = 2 * i + (lane >> 5); float w = W[(size_t)(k0 + kk) * N + n0 + (lane & 31)]; if (kscale) w *= kscale[k0 + kk]; scr[kk * 33 + (lane & 31)] = w; }
    asm volatile("s_waitcnt lgkmcnt(0)" ::: "memory");
    const int drow0 = relabel ? (n0 & ~255) + 128 * ((n0 >> 5) & 1) + 32 * ((n0 >> 6) & 3) : n0;
    const int c = lane & 7;
#pragma unroll
    for (int j = 0; j < 4; ++j) { const int n = (lane >> 3) + 8 * j; const LAS float* s = scr + (8 * c) * 33 + n;
        v4u o; o.x = pk2(s[0 * 33], s[1 * 33]); o.y = pk2(s[2 * 33], s[3 * 33]); o.z = pk2(s[4 * 33], s[5 * 33]); o.w = pk2(s[6 * 33], s[7 * 33]);
        *(v4u*)(WT + (size_t)(drow0 + n) * ldw + koff + k0 + 8 * c) = o; }
    asm volatile("s_waitcnt lgkmcnt(0)" ::: "memory");
}

__device__ __forceinline__ void p0_ssm_setup(LAS float* Lf, int g, int tid, const float* are, const float* aim, const float* logdt, const float* bre, const float* bim,
                                             const float* cre, const float* cim, const float* dvec, bf16* Mcat, bf16* Mstate, float* lam1, float* lam32, float* BbW) {
    LAS float* pwr = Lf;
    LAS float* pwi = Lf + 4224;
    LAS float* Bbr = Lf + 8448;
    LAS float* Bbi = Lf + 10496;
    LAS float* Cr = Lf + 12544;
    LAS float* Ci = Lf + 14592;
    LAS float* Kt = Lf + 16640;
    if (tid < 128) {
        const int d = tid >> 6, n = tid & 63, pi = (d * NGRP + g) * NST + n;
        const double dt = dexp_((double)logdt[d * NGRP + g]);
        const double lre = fmin((double)are[pi], (double)(-1e-4f)), lim = (double)aim[pi];
        const double xr = lre * dt, xi = lim * dt;
        for (int k = 0; k <= 32; ++k) { double s, c; dsincos_(xi * k, s, c); const double mg = dexp_(xr * k); pwr[(d * 33 + k) * 64 + n] = (float)(mg * c); pwi[(d * 33 + k) * 64 + n] = (float)(mg * s); }
        double s1, c1; dsincos_(xi, s1, c1); const double mg1 = dexp_(xr);
        const double nr = mg1 * c1 - 1.0, ni = mg1 * s1, den = lre * lre + lim * lim;
        const double fre = (nr * lre + ni * lim) / den, fim = (ni * lre - nr * lim) / den;
        for (int p = 0; p < GP; ++p) { const double br = bre[(size_t)pi * GP + p], bi = bim[(size_t)pi * GP + p];
            const float vr = (float)(fre * br - fim * bi), vi = (float)(fre * bi + fim * br);
            Bbr[(d * 64 + n) * 16 + p] = vr; Bbi[(d * 64 + n) * 16 + p] = vi;
            BbW[(((size_t)(g * 2 + d) * 64 + n) * 16 + p) * 2] = vr; BbW[(((size_t)(g * 2 + d) * 64 + n) * 16 + p) * 2 + 1] = vi; }
        lam1[((g * 2 + d) * 64 + n) * 2] = (float)(mg1 * c1); lam1[((g * 2 + d) * 64 + n) * 2 + 1] = (float)(mg1 * s1);
        { double s, c; dsincos_(xi * 32, s, c); const double mg = dexp_(xr * 32); lam32[((g * 2 + d) * 64 + n) * 2] = (float)(mg * c); lam32[((g * 2 + d) * 64 + n) * 2 + 1] = (float)(mg * s); }
    } else {
        for (int e = tid - 128; e < 4096; e += 384) { const int which = e >> 11, idx = e & 2047, d = idx >> 10, pn_ = idx & 1023;
            const float v = (which ? cim : cre)[(size_t)(d * NGRP + g) * 1024 + pn_];
            if (which) Ci[idx] = v; else Cr[idx] = v; }
    }
    __syncthreads();
    for (int it = 0; it < 2; ++it) { const int combo = tid + 512 * it, d = combo >> 9, k = (combo >> 4) & 31, p = combo & 15;
        float acc[16];
#pragma unroll
        for (int q = 0; q < 16; ++q) acc[q] = 0.f;
        for (int n = 0; n < 64; ++n) { const float pr = pwr[(d * 33 + k) * 64 + n], pi_ = pwi[(d * 33 + k) * 64 + n], cr = Cr[(d * 16 + p) * 64 + n], ci = Ci[(d * 16 + p) * 64 + n];
            const float cwr = cr * pr - ci * pi_, cwi = cr * pi_ + ci * pr;
#pragma unroll
            for (int q = 0; q < 16; ++q) acc[q] += cwr * Bbr[(d * 64 + n) * 16 + q] - cwi * Bbi[(d * 64 + n) * 16 + q]; }
#pragma unroll
        for (int q = 0; q < 16; ++q) Kt[(d * 32 + k) * 256 + p * 16 + q] = acc[q]; }
    __syncthreads();
    for (int it = 0; it < 64; ++it) { const int chunk = tid + 512 * it, row = chunk >> 6, cc = (chunk & 63) * 8, i = row >> 4, p = row & 15, s = cc >> 4, p0 = cc & 15;
        const int lag = (s < i) ? (i - s) : (32 + s - i); const bool dg = (s == i);
        const float dd = dg ? dvec[g * GP + p] : 0.f;
        float v[8];
#pragma unroll
        for (int e = 0; e < 8; ++e) { const float a = Kt[lag * 256 + p * 16 + p0 + e], b = Kt[p * 16 + p0 + e]; v[e] = a + (dg ? b : 0.f) + ((p0 + e) == p ? dd : 0.f); }
        v4u o; o.x = pk2(v[0], v[1]); o.y = pk2(v[2], v[3]); o.z = pk2(v[4], v[5]); o.w = pk2(v[6], v[7]);
        *(v4u*)(Mcat + ((size_t)g * 512 + row) * KCAT + cc) = o; }
    for (int it = 0; it < 32; ++it) { const int chunk = tid + 512 * it, row = chunk >> 5, col = (chunk & 31) * 8, i = row >> 4, p = row & 15, d = col >> 7, reim = (col >> 6) & 1, n0 = col & 63, ex = d ? (32 - i) : (i + 1);
        float v[8];
#pragma unroll
        for (int e = 0; e < 8; ++e) { const int n = n0 + e; const float cr = Cr[(d * 16 + p) * 64 + n], ci = Ci[(d * 16 + p) * 64 + n], pr = pwr[(d * 33 + ex) * 64 + n], pi_ = pwi[(d * 33 + ex) * 64 + n];
            v[e] = reim ? -(cr * pi_ + ci * pr) : (cr * pr - ci * pi_); }
        v4u o; o.x = pk2(v[0], v[1]); o.y = pk2(v[2], v[3]); o.z = pk2(v[4], v[5]); o.w = pk2(v[6], v[7]);
        *(v4u*)(Mcat + ((size_t)g * 512 + row) * KCAT + 512 + col) = o; }
    for (int it = 0; it < 32; ++it) { const int chunk = tid + 512 * it, row = chunk >> 6, cc = (chunk & 63) * 8, d = row >> 7, reim = (row >> 6) & 1, n = row & 63, s = cc >> 4, p0 = cc & 15, ex = d ? s : (31 - s);
        const float pr = pwr[(d * 33 + ex) * 64 + n], pi_ = pwi[(d * 33 + ex) * 64 + n];
        float v[8];
#pragma unroll
        for (int e = 0; e < 8; ++e) { const float br = Bbr[(d * 64 + n) * 16 + p0 + e], bi = Bbi[(d * 64 + n) * 16 + p0 + e]; v[e] = reim ? (pr * bi + pi_ * br) : (pr * br - pi_ * bi); }
        v4u o; o.x = pk2(v[0], v[1]); o.y = pk2(v[2], v[3]); o.z = pk2(v[4], v[5]); o.w = pk2(v[6], v[7]);
        *(v4u*)(Mstate + ((size_t)g * 256 + row) * 512 + cc) = o; }
    __syncthreads();
}

__device__ __forceinline__ void p0_meta_item(LAS float* Lf, int it, int tid, int lane, int wave, const float* meta, const float* gmix, const float* Win, const float* kg, float* umeta, bf16* Kb, bf16* Vb) {
    LAS float* hm = Lf;
    LAS float* red = Lf + 16384;
    LAS float* res = Lf + 24576;
    const int col0 = it < 8 ? 64 * it : (it < 12 ? 1536 + 64 * (it - 8) : 1792 + 64 * (it - 12));
    for (int rr = 0; rr < 2; ++rr) { const int r = 2 * wave + rr; float v[16]; float ss = 0.f;
#pragma unroll
        for (int j = 0; j < 16; ++j) { v[j] = meta[r * D + 64 * j + lane]; ss += v[j] * v[j]; }
        const float rinv = 1.0f / sqrtf(wave_sum(ss) * (1.0f / D) + NORM_EPS);
#pragma unroll
        for (int j = 0; j < 16; ++j) hm[r * D + 64 * j + lane] = v[j] * rinv * gmix[64 * j + lane]; }
    __syncthreads();
    { const int cl = tid & 63, ks = tid >> 6; float acc[16];
#pragma unroll
        for (int r = 0; r < 16; ++r) acc[r] = 0.f;
#pragma unroll 4
        for (int kk = 0; kk < 128; ++kk) { const int k = ks * 128 + kk; const float w = Win[(size_t)k * INW + col0 + cl];
#pragma unroll
            for (int r = 0; r < 16; ++r) acc[r] += hm[r * D + k] * w; }
#pragma unroll
        for (int r = 0; r < 16; ++r) red[(ks * 16 + r) * 64 + cl] = acc[r]; }
    __syncthreads();
    for (int q = 0; q < 2; ++q) { const int o = tid + 512 * q, r = o >> 6, c = o & 63; float s = 0.f;
#pragma unroll
        for (int ks = 0; ks < 8; ++ks) s += red[(ks * 16 + r) * 64 + c];
        res[o] = s; if (it < 8) umeta[r * SSMW + col0 + c] = s; }
    __syncthreads();
    if (it >= 8) { const int head = (it - 8) & 3; const bool isk = it < 12;
        for (int rr = 0; rr < 2; ++rr) { const int r = 2 * wave + rr; float v = res[r * 64 + lane];
            if (isk) { const float ss = wave_sum(v * v); v = v * (1.0f / sqrtf(ss * (1.0f / 64.0f) + NORM_EPS)) * kg[lane]; }
            const bf16 o = (bf16)f2bf(v); bf16* T = isk ? Kb : Vb;
            for (int b = 0; b < BATCH; ++b) T[((size_t)b * KVR + SEQ + r) * 256 + head * 64 + lane] = o; } }
    __syncthreads();
}


#define XB_TMO      128
#define XB_XCNT(j)  (256  + 64 * (j))
#define XB_XSUB(j)  (1280 + 64 * (j))
#define XB_XGEN(j)  (2304 + 64 * (j))
#define XB_TOP      3328
#define XB_TOPGEN   3392
#define XCD_BAR_WORDS 3456
#define XB_SPIN_CAP (1u << 18)

__device__ __forceinline__ unsigned xb_ld(unsigned* p)              { return __hip_atomic_load(p, __ATOMIC_RELAXED, __HIP_MEMORY_SCOPE_AGENT); }
__device__ __forceinline__ unsigned xb_add(unsigned* p, unsigned v) { return __hip_atomic_fetch_add(p, v, __ATOMIC_RELAXED, __HIP_MEMORY_SCOPE_AGENT); }
__device__ __forceinline__ unsigned xb_xcc_id() { return (unsigned)__builtin_amdgcn_s_getreg((3 << 11) | 20) & 0xFu; }
#define XB_SPIN(cond, bar) do { unsigned _sp = 0; while (cond) { __builtin_amdgcn_s_sleep(1); \
    if ((++_sp & 255u) == 0u) { if (xb_ld(&(bar)[XB_TMO])) break; if (_sp > XB_SPIN_CAP) { atomicAdd(&(bar)[XB_TMO], 1u); break; } } } } while (0)

struct XcdBarrier {
    unsigned* bar; unsigned x;
    volatile LAS unsigned* st;
};

__device__ __forceinline__ XcdBarrier xcd_barrier_post(unsigned* bar, volatile LAS unsigned* st) {
    XcdBarrier b; b.bar = bar; b.x = xb_xcc_id(); b.st = st;
    if (threadIdx.x == 0) (void)xb_add(&bar[XB_XCNT(b.x)], 1u);
    return b;
}
__device__ __forceinline__ void xcd_barrier_complete(unsigned* bar, unsigned x, unsigned& nloc, unsigned& nx) {
    const unsigned G = gridDim.x * gridDim.y * gridDim.z;
    unsigned sum, cnt, mine, sp = 0u;
    for (;;) {
        sum = 0u; cnt = 0u; mine = 0u;
#pragma unroll
        for (unsigned j = 0; j < 16; ++j) { const unsigned c = xb_ld(&bar[XB_XCNT(j)]); sum += c; cnt += (c > 0u) ? 1u : 0u; mine = (j == x) ? c : mine; }
        if (sum == G) break;
        __builtin_amdgcn_s_sleep(1);
        if ((++sp & 255u) == 0u) { if (xb_ld(&bar[XB_TMO])) break; if (sp > XB_SPIN_CAP) { atomicAdd(&bar[XB_TMO], 1u); break; } }
    }
    nloc = mine > 0u ? mine : 1u; nx = cnt > 0u ? cnt : 1u;
}

__device__ __forceinline__ void xcd_barrier(const XcdBarrier& b) {
    asm volatile("s_waitcnt vmcnt(0)" ::: "memory");
    __syncthreads();
    if (threadIdx.x == 0) {
        unsigned* bar = b.bar;
        __builtin_amdgcn_s_waitcnt(0);
        unsigned nloc = b.st[0], nx = b.st[1];
        if (nloc == 0u) { xcd_barrier_complete(bar, b.x, nloc, nx); b.st[0] = nloc; b.st[1] = nx; }
        const unsigned old = xb_add(&bar[XB_XSUB(b.x)], 1u);
        const unsigned gen = old / nloc;
        if (old + 1u == (gen + 1u) * nloc) {
            __builtin_amdgcn_fence(__ATOMIC_RELEASE, "agent");
            asm volatile("s_waitcnt vmcnt(0)" ::: "memory");
            const unsigned og = xb_add(&bar[XB_TOP], 1u);
            const unsigned tg = og / nx;
            if (og + 1u == (tg + 1u) * nx) xb_add(&bar[XB_TOPGEN], 1u);
            else XB_SPIN(xb_ld(&bar[XB_TOPGEN]) == tg, bar);
            __builtin_amdgcn_fence(__ATOMIC_ACQUIRE, "agent");
            xb_add(&bar[XB_XGEN(b.x)], 1u);
            asm volatile("s_waitcnt vmcnt(0)" ::: "memory");
        } else {
            XB_SPIN(xb_ld(&bar[XB_XGEN(b.x)]) == gen, bar);
            __builtin_amdgcn_fence(__ATOMIC_ACQUIRE, "agent");
            asm volatile("s_waitcnt vmcnt(0)" ::: "memory");
        }
    }
    __syncthreads();
}

#define barw ((unsigned*)(ws + WS_BAR))
#define rss1 ((float*)(ws + WS_RSS1))
#define rss2 ((float*)(ws + WS_RSS2))
#define rope ((float*)(ws + WS_ROPE))
#define umeta ((float*)(ws + WS_UMETA))
#define lam1 ((float*)(ws + WS_LAM1))
#define lam32 ((float*)(ws + WS_LAM32))
#define BbW ((float*)(ws + WS_BBW))
#define WinT ((bf16*)(ws + WS_WIN))
#define WgluT ((bf16*)(ws + WS_WGLU))
#define PcatT ((bf16*)(ws + WS_PCAT))
#define xnrm ((float*)(ws + WS_XNRM))
#define WoutT ((bf16*)(ws + WS_WOUT))
#define W1T ((bf16*)(ws + WS_W1))
#define W2T ((bf16*)(ws + WS_W2))
#define Mcat ((bf16*)(ws + WS_MCAT))
#define Mstate ((bf16*)(ws + WS_MSTATE))
#define XN ((bf16*)(ws + WS_R1))
#define H1B ((bf16*)(ws + WS_R1))
#define Acat ((bf16*)(ws + WS_ACAT))
#define Sst ((float*)(ws + WS_S))
#define YQO ((bf16*)(ws + WS_YQO))
#define Kb ((bf16*)(ws + WS_K))
#define Vb ((bf16*)(ws + WS_V))
#define Zb ((bf16*)(ws + WS_Z))
#define MRG ((bf16*)(ws + WS_MERGED))
#define HID ((bf16*)(ws + WS_HID))
#define GT ((bf16*)(ws + WS_GATES))
#ifndef PH_MASK
#define PH_MASK 0xFFFF
#endif
#define PH(k) ((PH_MASK >> (k)) & 1)
struct Args { const float* in[23]; float* out; unsigned char* ws; };

__global__ void __launch_bounds__(512, 2) mk_fwd(Args args) {
    extern __shared__ __attribute__((aligned(16))) unsigned char lds[];
    cg::grid_group grid = cg::this_grid();
    const int tid = threadIdx.x, lane = tid & 63, wave = __builtin_amdgcn_readfirstlane(tid >> 6);
    const int G = gridDim.x, bx = blockIdx.x;
    const int vcu = (G % 8 == 0) ? (bx % 8) * (G / 8) + bx / 8 : bx;
    unsigned char* ws = args.ws;
    PG8_LAS unsigned char* L8 = (PG8_LAS unsigned char*)lds;
    volatile LAS unsigned* MISC = (volatile LAS unsigned*)((LAS unsigned char*)lds + (LDS_BYTES - 64));
    if (tid < 16) MISC[tid] = 0u;
    __syncthreads();
    LAS float* Lf = (LAS float*)lds;

#if PH(0)
    if (bx < 32) {
        p0_ssm_setup(Lf, bx, tid, args.in[4], args.in[5], args.in[6], args.in[7], args.in[8], args.in[9], args.in[10], args.in[11], Mcat, Mstate, lam1, lam32, BbW);
    } else if (bx < 48) {
        p0_meta_item(Lf, bx - 32, tid, lane, wave, args.in[1], args.in[2], args.in[3], args.in[15], umeta, Kb, Vb);
    } else if (bx < 64) {
        const int b = (bx - 48) >> 1; unsigned char* T = (unsigned char*)(((bx - 48) & 1) ? Vb : Kb);
        for (int q = 0; q < 3; ++q) { const int idx = tid + 512 * q;
            *(v4u*)(T + ((size_t)b * KVR + SEQ + 16) * 512 + (size_t)idx * 16) = (v4u){0u, 0u, 0u, 0u}; }
    } else if (bx == 64) {
        for (int q = 0; q < 4; ++q) { const int e = tid + 512 * q, pos = e >> 4, j = e & 15; double s, c;
            dsincos_((double)pos * dexp_(-(double)j * (9.21034037197618273607 / 16.0)), s, c); rope[2 * e] = (float)c; rope[2 * e + 1] = (float)s; }
    }
    {
        for (int i = bx * 512 + tid; i < 2 * M; i += G * 512) rss1[i] = 0.f;
        if (bx == 0) for (int i = tid; i < XCD_BAR_WORDS; i += 512) barw[i] = 0u;
        LAS float* scr = (LAS float*)(lds + wave * 16384);
        constexpr int NSPECIAL = 48;
        const int gw = (bx - NSPECIAL) * 8 + wave, NGW = (G - NSPECIAL) * 8;
        if (bx >= NSPECIAL) {
        constexpr int I_IN = (D / 64) * (INW / 32), I_GLU = (SSMW / 64) * (SSMW / 32), I_PS = (SSMW / 64) * (D / 32), I_PA = (D / 64) * (D / 32), I_WO = I_PA, I_1 = (D / 64) * (FF / 32), I_2 = (FF / 64) * (D / 32);
        constexpr int NITEMS = I_IN + I_GLU + I_PS + I_PA + I_WO + I_1 + I_2;
        for (int it = gw; it < NITEMS; it += NGW) {
            int r = it;
            if (r < I_IN) { p0_transpose_item(args.in[3], D, INW, WinT, D, 0, args.in[2], true, scr, r, lane); continue; } r -= I_IN;
            if (r < I_GLU) { p0_transpose_item(args.in[12], SSMW, SSMW, WgluT, SSMW, 0, nullptr, false, scr, r, lane); continue; } r -= I_GLU;
            if (r < I_PS) { p0_transpose_item(args.in[16], SSMW, D, PcatT, QP, 0, nullptr, false, scr, r, lane); continue; } r -= I_PS;
            if (r < I_PA) { p0_transpose_item(args.in[17], D, D, PcatT, QP, SSMW, nullptr, false, scr, r, lane); continue; } r -= I_PA;
            if (r < I_WO) { p0_transpose_item(args.in[18], D, D, WoutT, D, 0, nullptr, false, scr, r, lane); continue; } r -= I_WO;
            if (r < I_1) { p0_transpose_item(args.in[20], D, FF, W1T, D, 0, args.in[19], false, scr, r, lane); continue; } r -= I_1;
            p0_transpose_item(args.in[21], FF, D, W2T, FF, 0, nullptr, false, scr, r, lane);
        }
        for (int m = 2 * gw; m < M; m += 2 * NGW) {
            const int m2 = m + 1;
            const f32x4* xr = (const f32x4*)(args.in[0] + (size_t)m * D) + lane; const f32x4* xr2 = (const f32x4*)(args.in[0] + (size_t)m2 * D) + lane;
            f32x4 v[4], w[4]; float s = 0.f, s2 = 0.f;
#pragma unroll
            for (int j = 0; j < 4; ++j) { v[j] = xr[64 * j]; w[j] = xr2[64 * j]; }
#pragma unroll
            for (int j = 0; j < 4; ++j) { s += (v[j].x * v[j].x + v[j].y * v[j].y) + (v[j].z * v[j].z + v[j].w * v[j].w); s2 += (w[j].x * w[j].x + w[j].y * w[j].y) + (w[j].z * w[j].z + w[j].w * w[j].w); }
            const float rms = sqrtf(wave_sum(s) * (1.0f / D) + NORM_EPS), rms2 = sqrtf(wave_sum(s2) * (1.0f / D) + NORM_EPS), rinv = 1.0f / rms, rinv2 = 1.0f / rms2;
            if (lane == 0) { xnrm[m] = rms; xnrm[m2] = rms2; }
            v2u* o8 = (v2u*)(XN + (size_t)m * D) + lane; v2u* o82 = (v2u*)(XN + (size_t)m2 * D) + lane;
#pragma unroll
            for (int j = 0; j < 4; ++j) { v2u q; q.x = pk2(v[j].x * rinv, v[j].y * rinv); q.y = pk2(v[j].z * rinv, v[j].w * rinv); o8[64 * j] = q;
                v2u q2; q2.x = pk2(w[j].x * rinv2, w[j].y * rinv2); q2.y = pk2(w[j].z * rinv2, w[j].w * rinv2); o82[64 * j] = q2; }
        }
        }
    }
    grid.sync();
    XcdBarrier bar = xcd_barrier_post(barw, MISC + 8);

#endif
#if PH(1)
    {
        pg8::Gemm g{XN, WinT, D, D, D, 0, 0}; pg8::StaticOrder S; S.init(M, INW, G, bx, M / 256);
        pg8::EpiInProj E{Acat, YQO + SSMW, Kb, Vb, GT, args.in[14], args.in[15], rope};
        pg8::gemm_phase<pg8::EpiInProj, pg8::StaticOrder, true, true>(L8, g, S, E);
    }
    xcd_barrier(bar);

#endif
#if PH(2)
    {
        pg8::Gemm g{Acat, Mstate, CT * GP, KCAT, CT * GP, (size_t)CROWS * KCAT, (size_t)256 * 512}; pg8::StaticOrder S; S.init(NGRP * CROWS, 256, G, bx, CROWS / 256);
        pg8::EpiScan E{Acat, lam1, lam32, BbW, umeta};
        pg8::gemm_phase<pg8::EpiScan, pg8::StaticOrder, false, true>(L8, g, S, E);
    }
    {
        const attn_body::AttnTensors AT{(const attn_body::bf16*)(YQO + SSMW), (const attn_body::bf16*)Kb, (const attn_body::bf16*)Vb, (attn_body::bf16*)(YQO + SSMW)};
        const attn_body::StaticOrder S((int)G, (int)bx);
        attn_body::attn_phase<attn_body::StaticOrder>((char*)lds, AT, S);
    }
    xcd_barrier(bar);

#endif
#if PH(4)
    {
        pg8::Gemm g{Acat, Mcat, KCAT, KCAT, KCAT, (size_t)CROWS * KCAT, (size_t)512 * KCAT}; pg8::StaticOrder S; S.init(NGRP * CROWS, 512, G, bx, CROWS / 256);
        pg8::EpiSsmC E{Zb};
        pg8::gemm_phase<pg8::EpiSsmC, pg8::StaticOrder, true, true>(L8, g, S, E);
    }
    xcd_barrier(bar);

#endif
#if PH(5)
    {
        pg8::Gemm g{Zb, WgluT, SSMW, SSMW, SSMW, 0, 0}; pg8::StaticOrder S; S.init(M, SSMW, G, bx, M / 256);
        pg8::EpiEw<0> E{YQO, QP, Zb, SSMW, 0, nullptr, 0, args.in[13]};
        pg8::gemm_phase<pg8::EpiEw<0>, pg8::StaticOrder, true, true>(L8, g, S, E);
    }
    xcd_barrier(bar);

#endif
#if PH(6)
    {
        pg8::Gemm g{YQO, PcatT, QP, QP, QP, 0, 0}; pg8::StaticOrder S; S.init(M, D, G, bx, M / 256);
        pg8::EpiGate E{MRG, GT};
        pg8::gemm_phase<pg8::EpiGate, pg8::StaticOrder, true, true>(L8, g, S, E);
    }
    xcd_barrier(bar);
#endif
#if PH(8)
    {
        pg8::Gemm g{MRG, WoutT, D, D, D, 0, 0}; pg8::StaticOrder S; S.init(M, D, G, bx, M / 256);
        pg8::EpiRes E{H1B, xnrm, rss1};
        pg8::gemm_phase<pg8::EpiRes, pg8::StaticOrder, true, true>(L8, g, S, E);
    }
    xcd_barrier(bar);

#endif
#if PH(9)
    {
        pg8::Gemm g{H1B, W1T, D, D, D, 0, 0}; pg8::StaticOrder S; S.init(M, FF, G, bx, M / 256);
        pg8::EpiEw<5> E{HID, FF, nullptr, 0, 0, nullptr, 0, rss1};
        pg8::gemm_phase<pg8::EpiEw<5>, pg8::StaticOrder, true, true>(L8, g, S, E);
    }
    xcd_barrier(bar);

#endif
#if PH(10)
    {
        pg8::Gemm g{HID, W2T, FF, FF, FF, 0, 0}; pg8::StaticOrder S; S.init(M, D, G, bx, M / 256);
        pg8::EpiRes E{H1B, nullptr, rss2};
        pg8::gemm_phase<pg8::EpiRes, pg8::StaticOrder, true, true>(L8, g, S, E);
    }
    xcd_barrier(bar);

#endif
#if PH(11)
    {
        const float* gf = args.in[22];
        const int gw = vcu * 8 + wave, NGW = G * 8;
        f32x4 gv[4];
#pragma unroll
        for (int j = 0; j < 4; ++j) gv[j] = ((const f32x4*)gf)[64 * j + lane];
        for (int m = gw; m < M; m += 4 * NGW) {
            v2u a[4][4]; float rr[4];
#pragma unroll
            for (int k = 0; k < 4; ++k) { const v2u* h = (const v2u*)(H1B + (size_t)(m + k * NGW) * D) + lane; rr[k] = rss2[m + k * NGW];
#pragma unroll
                for (int j = 0; j < 4; ++j) a[k][j] = h[64 * j]; }
#pragma unroll
            for (int k = 0; k < 4; ++k) { const float ra = 1.0f / sqrtf(rr[k] * (1.0f / D) + NORM_EPS); f32x4* o0 = (f32x4*)(args.out + (size_t)(m + k * NGW) * D) + lane;
#pragma unroll
                for (int j = 0; j < 4; ++j) { f32x4 v = {pg8::bf_lo(a[k][j].x), pg8::bf_hi(a[k][j].x), pg8::bf_lo(a[k][j].y), pg8::bf_hi(a[k][j].y)}; o0[64 * j] = v * ra * gv[j]; } }
        }
    }
#endif
}

extern "C" void kernel_launch(void* const* d_in, const int* in_sizes, int n_in, void* d_out, int out_size, void* d_ws, size_t ws_size, hipStream_t stream) {
    static int grid = 0;
    if (grid == 0) {
        if (n_in != 23 || in_sizes[0] != M * D || in_sizes[3] != D * INW || out_size != M * D || ws_size < WS_END) {
            fprintf(stderr, "kernel_launch: unexpected shapes (n_in %d, in0 %d, in3 %d, out %d, ws %zu); nothing launched\n", n_in, n_in > 0 ? in_sizes[0] : -1, n_in > 3 ? in_sizes[3] : -1, out_size, ws_size); grid = -1; return; }
        int dev = 0, cus = 0, per_cu = 0;
        if (hipGetDevice(&dev) != hipSuccess || hipDeviceGetAttribute(&cus, hipDeviceAttributeMultiprocessorCount, dev) != hipSuccess) { grid = -1; return; }
        if (hipFuncSetAttribute((const void*)mk_fwd, hipFuncAttributeMaxDynamicSharedMemorySize, LDS_BYTES) != hipSuccess) { fprintf(stderr, "kernel_launch: hipFuncSetAttribute failed\n"); grid = -1; return; }
        if (hipOccupancyMaxActiveBlocksPerMultiprocessor(&per_cu, (const void*)mk_fwd, 512, LDS_BYTES) != hipSuccess || per_cu < 1) { fprintf(stderr, "kernel_launch: occupancy query says %d\n", per_cu); per_cu = 1; }
        (void)hipGetLastError();
        grid = cus * per_cu;
        if (grid != 256) { fprintf(stderr, "kernel_launch: this kernel's static schedules need exactly 256 resident workgroups, got %d x %d; nothing launched\n", cus, per_cu); grid = -1; return; }
    }
    if (grid < 0) return;
    Args a{};
    for (int i = 0; i < 23; ++i) a.in[i] = (const float*)d_in[i];
    a.out = (float*)d_out; a.ws = (unsigned char*)d_ws;
    void* kargs[] = {&a};
    const hipError_t e = hipLaunchCooperativeKernel((const void*)mk_fwd, dim3(grid), dim3(512), kargs, LDS_BYTES, stream);
    if (e != hipSuccess) fprintf(stderr, "kernel_launch: cooperative launch failed: %s\n", hipGetErrorString(e));
}
```

```cpp
#include <hip/hip_runtime.h>
#include <hip/hip_cooperative_groups.h>
#include <hip/hip_bf16.h>
#include <cstdio>
#include <cstdint>
#include <cmath>
namespace cg = cooperative_groups;

constexpr int BATCH = 8, SEQ = 8192, D = 1024, NMETA = 16, NH = 16, NKVH = 4, HD = 64, FF = 4096;
constexpr int M = BATCH * SEQ;
constexpr int INW = 4096;
constexpr int SSMW = 512, NGRP = 32, NST = 64, GP = 16;
constexpr int CT = 32;
constexpr int NCH = SEQ / CT;
constexpr int CROWS = BATCH * NCH;
constexpr int KCAT = CT * GP + 4 * NST;
constexpr int KVR = SEQ + 64;
constexpr float NORM_EPS = 1e-6f;
constexpr int QP = 1536;
constexpr float C2Q = 0.125f * 1.4426950408889634f;

namespace pg8 {
#define PG8_LAS __attribute__((address_space(3)))
typedef unsigned short bf16_t;
typedef short bf16x8 __attribute__((ext_vector_type(8)));
typedef float f32x4 __attribute__((ext_vector_type(4)));
typedef unsigned u32x4 __attribute__((ext_vector_type(4)));
typedef unsigned u32x2 __attribute__((ext_vector_type(2)));
constexpr int BM = 256, BK = 64, HALF = 128, HTB = HALF * BK * 2  , STAGE_BYTES = 8 * HTB, NXCD = 8, WGM = 4;

__host__ __device__ __forceinline__ int lds_byte(int r, int c) { const int st = (r >> 4) * 2 + (c >> 5), rr = r & 15, cc = c & 31, ob = rr * 64 + cc * 2; return st * 1024 + (ob ^ (((ob >> 9) & 1) << 5)); }
__host__ __device__ __forceinline__ void stage_rc(int b, int& R, int& C) { const int st = b / 1024, sb = b % 1024, swz = sb ^ (((sb >> 9) & 1) << 5); R = (st >> 1) * 16 + swz / 64; C = (st & 1) * 32 + (swz % 64) / 2; }
__host__ __device__ __forceinline__ int perm32(int rho) { const int n = rho >> 4, i = rho & 15; return 8 * (i >> 2) + 4 * n + (i & 3); }

struct Unit { int pm, pn, g; };
struct Gemm { const bf16_t* A; const bf16_t* Bt; int K, lda, ldb; size_t sA, sB; };

struct StaticOrder {
    int nM, nN, nwg, G, c, mpb;
    __host__ __device__ void init(int Mtot, int N, int G_, int c_, int mpb_) { nM = Mtot / BM; nN = N / BM; nwg = nM * nN; G = G_; c = c_; mpb = mpb_; }
    __host__ __device__ bool next(int i, Unit& u) const {
        const long L = (long)i * G + c; if (L >= nwg) return false;
        int wgid = (int)L; { const int q = nwg / NXCD, r = nwg % NXCD, xcd = wgid % NXCD, off = wgid / NXCD; wgid = (xcd < r ? xcd * (q + 1) : r * (q + 1) + (xcd - r) * q) + off; }
        const int nig = WGM * nN, gid = wgid / nig, fm = gid * WGM, gsz = (nM - fm) < WGM ? (nM - fm) : WGM;
        const int pmt = fm + ((wgid % nig) % gsz); u.pn = (wgid % nig) / gsz; u.g = pmt / mpb; u.pm = pmt % mpb; return true;
    }
};

__device__ __forceinline__ unsigned cvt_pk_bf16(float lo, float hi) { unsigned r; asm volatile("v_cvt_pk_bf16_f32 %0, %1, %2" : "=v"(r) : "v"(lo), "v"(hi)); return r; }
typedef float f32x2 __attribute__((ext_vector_type(2)));
__device__ __forceinline__ f32x2 gelu_pk(f32x2 v) {
    const f32x2 av = __builtin_elementwise_abs(v), d = av * 0.2316418882f + 1.0f;
    f32x2 t; t.x = __builtin_amdgcn_rcpf(d.x); t.y = __builtin_amdgcn_rcpf(d.y);
    f32x2 q = t * 0.5307027145f + (-0.7265760135f); q = q * t + 0.7107068705f; q = q * t + (-0.142248368f); q = q * t + 0.127414796f; q = q * t;
    const f32x2 s = (v * v) * (-0.72134752044f);
    f32x2 e; e.x = __builtin_amdgcn_exp2f(s.x); e.y = __builtin_amdgcn_exp2f(s.y);
    const f32x2 m = v * (q * e), r = v - m;
    f32x2 o; o.x = v.x < 0.f ? m.x : r.x; o.y = v.y < 0.f ? m.y : r.y; return o;
}
__device__ __forceinline__ float sigmoidf_(float x) { return __builtin_amdgcn_rcpf(1.0f + __builtin_amdgcn_exp2f(-1.4426950408889634f * x)); }
__device__ __forceinline__ float bf_lo(unsigned w) { return __uint_as_float(w << 16); }
__device__ __forceinline__ float bf_hi(unsigned w) { return __uint_as_float(w & 0xffff0000u); }
__device__ __forceinline__ u32x4 pack8(const f32x4 a, const f32x4 b) { u32x4 w; w.x = cvt_pk_bf16(a[0], a[1]); w.y = cvt_pk_bf16(a[2], a[3]); w.z = cvt_pk_bf16(b[0], b[1]); w.w = cvt_pk_bf16(b[2], b[3]); return w; }


struct EpiInProj {
    static constexpr bool PERM = true, AFTER_DRAIN = false; static constexpr int MID_T = -1;
    bf16_t* Acat; bf16_t* Q; bf16_t* Kb; bf16_t* Vb; bf16_t* Gt; const float* qg; const float* kg; const float* rope;
    __device__ __forceinline__ void operator()(const f32x4 (&acc)[2][2][4][2], const Unit& u, int wr, int wc, int fr, int fq) const {
        const int pn = u.pn, rowb = u.pm * BM + wr * 64 + fr;
        if (pn < 2) {
#pragma unroll
            for (int ai = 0; ai < 2; ++ai)
#pragma unroll
                for (int m = 0; m < 4; ++m) { const int row = rowb + ai * HALF + m * 16;
#pragma unroll
                    for (int bj = 0; bj < 2; ++bj) { const int g = 16 * pn + 4 * wc + 2 * bj + (fq >> 1);
                        bf16_t* dst = Acat + ((size_t)g * CROWS + (row >> 5)) * KCAT + (row & 31) * 16 + 8 * (fq & 1);
                        *(u32x4*)dst = pack8(acc[ai][bj][m][0], acc[ai][bj][m][1]); } }
        } else if (pn < 7) {
            const bool isq = pn < 6; const float* gsrc = isq ? qg : kg;
            f32x4 gq[2][2];
#pragma unroll
            for (int bj = 0; bj < 2; ++bj)
#pragma unroll
                for (int n = 0; n < 2; ++n) gq[bj][n] = *(const f32x4*)(gsrc + 32 * bj + 8 * fq + 4 * n);
            const float post = isq ? C2Q : 1.0f;
#pragma unroll
            for (int ai = 0; ai < 2; ++ai) {
                f32x4 cs[4][2][2];
#pragma unroll
                for (int m = 0; m < 4; ++m) { const int t = (rowb + ai * HALF + m * 16) & (SEQ - 1);
#pragma unroll
                    for (int bj = 0; bj < 2; ++bj) { const int pos = bj ? (t & 63) : (t >> 6); const f32x4* rp = (const f32x4*)(rope + (pos * 16 + 4 * fq) * 2); cs[m][bj][0] = rp[0]; cs[m][bj][1] = rp[1]; } }
                asm volatile("" ::: "memory");
#pragma unroll
                for (int m = 0; m < 4; ++m) { const int row = rowb + ai * HALF + m * 16, t = row & (SEQ - 1), b = row >> 13;
                    float ss = 0.f;
#pragma unroll
                    for (int bj = 0; bj < 2; ++bj)
#pragma unroll
                        for (int n = 0; n < 2; ++n) { const f32x4 x = acc[ai][bj][m][n]; ss += (x[0] * x[0] + x[1] * x[1]) + (x[2] * x[2] + x[3] * x[3]); }
                    ss += __shfl_xor(ss, 16); ss += __shfl_xor(ss, 32);
                    const float rn = __builtin_amdgcn_rsqf(ss * (1.0f / 64.0f) + NORM_EPS) * post;
                    bf16_t* dst = isq ? Q + (size_t)row * QP + ((pn - 2) * 4 + wc) * 64 + 8 * fq
                                      : Kb + ((size_t)b * KVR + t) * 256 + wc * 64 + 8 * fq;
#pragma unroll
                    for (int bj = 0; bj < 2; ++bj) {
                        const f32x4 cs0 = cs[m][bj][0], cs1 = cs[m][bj][1];
                        const f32x4 v0 = acc[ai][bj][m][0] * gq[bj][0] * rn, v1 = acc[ai][bj][m][1] * gq[bj][1] * rn;
                        f32x4 o0, o1;
                        o0[0] = v0[0] * cs0[0] - v0[1] * cs0[1]; o0[1] = v0[0] * cs0[1] + v0[1] * cs0[0]; o0[2] = v0[2] * cs0[2] - v0[3] * cs0[3]; o0[3] = v0[2] * cs0[3] + v0[3] * cs0[2];
                        o1[0] = v1[0] * cs1[0] - v1[1] * cs1[1]; o1[1] = v1[0] * cs1[1] + v1[1] * cs1[0]; o1[2] = v1[2] * cs1[2] - v1[3] * cs1[3]; o1[3] = v1[2] * cs1[3] + v1[3] * cs1[2];
                        *(u32x4*)(dst + 32 * bj) = pack8(o0, o1); } } }
        } else if (pn == 7) {
#pragma unroll
            for (int ai = 0; ai < 2; ++ai)
#pragma unroll
                for (int m = 0; m < 4; ++m) { const int row = rowb + ai * HALF + m * 16, t = row & (SEQ - 1), b = row >> 13;
                    bf16_t* dst = Vb + ((size_t)b * KVR + t) * 256 + wc * 64 + 8 * fq;
#pragma unroll
                    for (int bj = 0; bj < 2; ++bj) *(u32x4*)(dst + 32 * bj) = pack8(acc[ai][bj][m][0], acc[ai][bj][m][1]); }
        } else {
#pragma unroll
            for (int ai = 0; ai < 2; ++ai)
#pragma unroll
                for (int m = 0; m < 4; ++m) { const int row = rowb + ai * HALF + m * 16;
                    bf16_t* dst = Gt + (size_t)row * 2048 + (pn - 8) * 256 + wc * 64 + 8 * fq;
#pragma unroll
                    for (int bj = 0; bj < 2; ++bj) { f32x4 a = acc[ai][bj][m][0], c = acc[ai][bj][m][1];
#pragma unroll
                        for (int e = 0; e < 4; ++e) { a[e] = sigmoidf_(a[e]); c[e] = sigmoidf_(c[e]); }
                        *(u32x4*)(dst + 32 * bj) = pack8(a, c); } }
        }
    }
};
struct EpiF32 {
    static constexpr bool PERM = false, AFTER_DRAIN = false; static constexpr int MID_T = -1;
    float* O; int ldc; size_t sO;
    __device__ __forceinline__ void operator()(const f32x4 (&acc)[2][2][4][2], const Unit& u, int wr, int wc, int fr, int fq) const {
        float* base = O + (size_t)u.g * sO + (size_t)(u.pm * BM + wr * 64 + fr) * ldc + u.pn * BM + wc * 32 + 4 * fq;
#pragma unroll
        for (int ai = 0; ai < 2; ++ai)
#pragma unroll
            for (int m = 0; m < 4; ++m)
#pragma unroll
                for (int bj = 0; bj < 2; ++bj)
#pragma unroll
                    for (int n = 0; n < 2; ++n) *(f32x4*)(base + (size_t)(ai * HALF + m * 16) * ldc + bj * HALF + n * 16) = acc[ai][bj][m][n];
    }
};
struct EpiScan {
    static constexpr bool PERM = false, AFTER_DRAIN = true; static constexpr int MID_T = -1;
    bf16_t* Acat; const float* lam1; const float* lam32; const float* BbW; const float* umeta;
    __device__ __forceinline__ unsigned short bfr(float f) const { unsigned u = __builtin_bit_cast(unsigned, f); return (unsigned short)((u + 0x7fffu + ((u >> 16) & 1u)) >> 16); }
    __device__ __forceinline__ void fused(f32x4 (&acc)[2][2][4][2], const Unit& u, int wr, int wc, int fr, int fq, PG8_LAS unsigned char* lds, int wid, int lane) const {
        constexpr int LS = 132;
        PG8_LAS float* Sl = (PG8_LAS float*)lds;
        PG8_LAS float* E = Sl + 256 * LS;
        PG8_LAS float* xm = E + 1024;
        const int tid = wid * 64 + lane, g = u.g, b = u.pm, n = tid & 63, seg = tid >> 6;
#pragma unroll
        for (int d = 0; d < 2; ++d) {
#pragma unroll
            for (int ai = 0; ai < 2; ++ai)
#pragma unroll
                for (int m = 0; m < 4; ++m)
#pragma unroll
                    for (int nn = 0; nn < 2; ++nn) *(PG8_LAS f32x4*)(Sl + (ai * HALF + wr * 64 + m * 16 + fr) * LS + wc * 32 + nn * 16 + 4 * fq) = acc[ai][d][m][nn];
            if (d == 0 && tid < 64) {
                const float l1r = lam1[((g * 2) * 64 + n) * 2], l1i = lam1[((g * 2) * 64 + n) * 2 + 1];
                const float* bb = BbW + ((size_t)(g * 2) * 64 + n) * 32;
                float mr = 0.f, mi = 0.f;
                for (int s = 0; s < NMETA; ++s) { float br = 0.f, bi = 0.f;
#pragma unroll
                    for (int p = 0; p < GP; ++p) { const float uu = umeta[s * SSMW + g * GP + p]; br += bb[2 * p] * uu; bi += bb[2 * p + 1] * uu; }
                    const float nr = l1r * mr - l1i * mi + br, ni = l1r * mi + l1i * mr + bi; mr = nr; mi = ni; }
                xm[2 * n] = mr; xm[2 * n + 1] = mi;
            }
            asm volatile("s_waitcnt lgkmcnt(0)" ::: "memory"); __builtin_amdgcn_s_barrier(); asm volatile("" ::: "memory");
            const float l32r = lam32[((g * 2 + d) * 64 + n) * 2], l32i = lam32[((g * 2 + d) * 64 + n) * 2 + 1];
            float xr = 0.f, xi = 0.f;
            {
                for (int j0 = 0; j0 < 32; j0 += 16) { float sr[16], si[16];
#pragma unroll
                    for (int e = 0; e < 16; ++e) { const int c = seg * 32 + (d ? 31 - j0 - e : j0 + e); sr[e] = Sl[c * LS + n]; si[e] = Sl[c * LS + 64 + n]; }
#pragma unroll
                    for (int e = 0; e < 16; ++e) { const float nr = l32r * xr - l32i * xi + sr[e], ni = l32r * xi + l32i * xr + si[e]; xr = nr; xi = ni; } }
                E[(seg * 64 + n) * 2] = xr; E[(seg * 64 + n) * 2 + 1] = xi;
            }
            asm volatile("s_waitcnt lgkmcnt(0)" ::: "memory"); __builtin_amdgcn_s_barrier(); asm volatile("" ::: "memory");
            {
                float pr = l32r, pi_ = l32i;
#pragma unroll
                for (int q = 0; q < 5; ++q) { const float a = pr * pr - pi_ * pi_, c2 = 2.f * pr * pi_; pr = a; pi_ = c2; }
                if (d == 0) { xr = xm[2 * n]; xi = xm[2 * n + 1];
                    for (int s = 0; s < seg; ++s) { const float er = E[(s * 64 + n) * 2], ei = E[(s * 64 + n) * 2 + 1]; const float nr = pr * xr - pi_ * xi + er, ni = pr * xi + pi_ * xr + ei; xr = nr; xi = ni; }
                } else { xr = 0.f; xi = 0.f;
                    for (int s = 7; s > seg; --s) { const float er = E[(s * 64 + n) * 2], ei = E[(s * 64 + n) * 2 + 1]; const float nr = pr * xr - pi_ * xi + er, ni = pr * xi + pi_ * xr + ei; xr = nr; xi = ni; } }
                for (int j0 = 0; j0 < 32; j0 += 16) { float sr[16], si[16];
#pragma unroll
                    for (int e = 0; e < 16; ++e) { const int cl = d ? 31 - j0 - e : j0 + e; sr[e] = Sl[(seg * 32 + cl) * LS + n]; si[e] = Sl[(seg * 32 + cl) * LS + 64 + n]; }
#pragma unroll
                    for (int e = 0; e < 16; ++e) { const int cl = d ? 31 - j0 - e : j0 + e;
                        Sl[(seg * 32 + cl) * LS + n] = xr; Sl[(seg * 32 + cl) * LS + 64 + n] = xi;
                        const float nr = l32r * xr - l32i * xi + sr[e], ni = l32r * xi + l32i * xr + si[e]; xr = nr; xi = ni; } }
            }
            asm volatile("s_waitcnt lgkmcnt(0)" ::: "memory"); __builtin_amdgcn_s_barrier(); asm volatile("" ::: "memory");
#pragma unroll
            for (int q = 0; q < 8; ++q) { const int piece = tid + 512 * q, row = piece >> 4, c8 = (piece & 15) * 8;
                const f32x4 a = *(const PG8_LAS f32x4*)(Sl + row * LS + c8), c = *(const PG8_LAS f32x4*)(Sl + row * LS + c8 + 4);
                *(u32x4*)(Acat + ((size_t)g * CROWS + b * NCH + row) * KCAT + 512 + d * 128 + c8) = pack8(a, c); }
            asm volatile("s_waitcnt lgkmcnt(0)" ::: "memory"); __builtin_amdgcn_s_barrier(); asm volatile("" ::: "memory");
        }
    }
};
struct EpiSsmC {
    static constexpr bool PERM = true, AFTER_DRAIN = false; static constexpr int MID_T = -1;
    bf16_t* Z;
    __device__ __forceinline__ void operator()(const f32x4 (&acc)[2][2][4][2], const Unit& u, int wr, int wc, int fr, int fq) const {
#pragma unroll
        for (int ai = 0; ai < 2; ++ai)
#pragma unroll
            for (int m = 0; m < 4; ++m) { const int R = u.pm * BM + wr * 64 + fr + ai * HALF + m * 16;
#pragma unroll
                for (int bj = 0; bj < 2; ++bj) { const int c = u.pn * BM + bj * HALF + wc * 32 + 8 * fq, i = c >> 4, p0 = c & 15;
                    const f32x4 v0 = acc[ai][bj][m][0], v1 = acc[ai][bj][m][1];
                    const f32x2 a = gelu_pk((f32x2){v0[0], v0[1]}), b = gelu_pk((f32x2){v0[2], v0[3]}), cc = gelu_pk((f32x2){v1[0], v1[1]}), dd = gelu_pk((f32x2){v1[2], v1[3]});
                    u32x4 w; w.x = cvt_pk_bf16(a.x, a.y); w.y = cvt_pk_bf16(b.x, b.y); w.z = cvt_pk_bf16(cc.x, cc.y); w.w = cvt_pk_bf16(dd.x, dd.y);
                    *(u32x4*)(Z + ((size_t)R * CT + i) * SSMW + u.g * GP + p0) = w; } }
    }
};
template <int MODE> struct EpiEw {
    static constexpr bool PERM = true, AFTER_DRAIN = false; static constexpr int MID_T = -1;
    bf16_t* O; int ldc; const bf16_t* In0; int ld0, off0; const bf16_t* In1; int ld1; const float* vec;
    __device__ __forceinline__ void operator()(const f32x4 (&acc)[2][2][4][2], const Unit& u, int wr, int wc, int fr, int fq) const {
        const int rowb = u.pm * BM + wr * 64 + fr, colb = u.pn * BM + wc * 32 + 8 * fq;
        f32x4 bv[2][2];
        if (MODE == 0) {
#pragma unroll
            for (int bj = 0; bj < 2; ++bj)
#pragma unroll
                for (int n = 0; n < 2; ++n) bv[bj][n] = *(const f32x4*)(vec + colb + bj * HALF + 4 * n);
        }
        u32x4 pre[2][4][2]; float rinv[2][4];
#pragma unroll
        for (int ai = 0; ai < 2; ++ai)
#pragma unroll
            for (int m = 0; m < 4; ++m) { const int row = rowb + ai * HALF + m * 16;
                rinv[ai][m] = 1.f; if (MODE == 5) rinv[ai][m] = vec[row];
                if (MODE == 0 || MODE == 1 || MODE == 2) {
#pragma unroll
                    for (int bj = 0; bj < 2; ++bj) pre[ai][m][bj] = *(const u32x4*)(In0 + (size_t)row * ld0 + off0 + colb + bj * HALF); } }
        asm volatile("" ::: "memory");
#pragma unroll
        for (int ai = 0; ai < 2; ++ai)
#pragma unroll
            for (int m = 0; m < 4; ++m) { const int row = rowb + ai * HALF + m * 16;
                float ri = 1.f; if (MODE == 5) ri = __builtin_amdgcn_rsqf(rinv[ai][m] * (1.0f / 1024.0f) + NORM_EPS);
#pragma unroll
                for (int bj = 0; bj < 2; ++bj) { const int col = colb + bj * HALF;
                    f32x4 v0 = acc[ai][bj][m][0], v1 = acc[ai][bj][m][1];
                    if (MODE == 0) { const u32x4 z = pre[ai][m][bj]; v0 += bv[bj][0]; v1 += bv[bj][1];
                        v0[0] = bf_lo(z.x) * sigmoidf_(v0[0]); v0[1] = bf_hi(z.x) * sigmoidf_(v0[1]); v0[2] = bf_lo(z.y) * sigmoidf_(v0[2]); v0[3] = bf_hi(z.y) * sigmoidf_(v0[3]);
                        v1[0] = bf_lo(z.z) * sigmoidf_(v1[0]); v1[1] = bf_hi(z.z) * sigmoidf_(v1[1]); v1[2] = bf_lo(z.w) * sigmoidf_(v1[2]); v1[3] = bf_hi(z.w) * sigmoidf_(v1[3]); }
                    if (MODE == 1 || MODE == 2) { const u32x4 g = pre[ai][m][bj];
                        v0[0] *= bf_lo(g.x); v0[1] *= bf_hi(g.x); v0[2] *= bf_lo(g.y); v0[3] *= bf_hi(g.y); v1[0] *= bf_lo(g.z); v1[1] *= bf_hi(g.z); v1[2] *= bf_lo(g.w); v1[3] *= bf_hi(g.w); }
                    if (MODE == 2) { const u32x4 t = *(const u32x4*)(In1 + (size_t)row * ld1 + col);
                        v0[0] += bf_lo(t.x); v0[1] += bf_hi(t.x); v0[2] += bf_lo(t.y); v0[3] += bf_hi(t.y); v1[0] += bf_lo(t.z); v1[1] += bf_hi(t.z); v1[2] += bf_lo(t.w); v1[3] += bf_hi(t.w); }
                    if (MODE == 5) {
#pragma unroll
                        for (int e = 0; e < 4; ++e) { float a = fmaxf(v0[e] * ri, 0.f), c = fmaxf(v1[e] * ri, 0.f); v0[e] = a * a; v1[e] = c * c; } }
                    *(u32x4*)(O + (size_t)row * ldc + col) = pack8(v0, v1); } }
    }
};
struct EpiRes {
    static constexpr bool PERM = true, AFTER_DRAIN = false; static constexpr int MID_T = -1;
    bf16_t* Hb; const float* rowscale; float* rss;
    __device__ __forceinline__ void operator()(const f32x4 (&acc)[2][2][4][2], const Unit& u, int wr, int wc, int fr, int fq) const {
        const int rowb = u.pm * BM + wr * 64 + fr, colb = u.pn * BM + wc * 32 + 8 * fq;
        u32x4 pre[2][4][2]; float rsv[2][4];
#pragma unroll
        for (int ai = 0; ai < 2; ++ai)
#pragma unroll
            for (int m = 0; m < 4; ++m) { const int row = rowb + ai * HALF + m * 16; rsv[ai][m] = rowscale ? rowscale[row] : 1.0f;
#pragma unroll
                for (int bj = 0; bj < 2; ++bj) pre[ai][m][bj] = *(const u32x4*)(Hb + (size_t)row * D + colb + bj * HALF); }
        asm volatile("" ::: "memory");
#pragma unroll
        for (int ai = 0; ai < 2; ++ai)
#pragma unroll
            for (int m = 0; m < 4; ++m) { const int row = rowb + ai * HALF + m * 16; float ss = 0.f; const float rs = rsv[ai][m];
#pragma unroll
                for (int bj = 0; bj < 2; ++bj) { const size_t off = (size_t)row * D + colb + bj * HALF;
                    const u32x4 t = pre[ai][m][bj];
                    f32x4 h0, h1;
                    h0[0] = bf_lo(t.x); h0[1] = bf_hi(t.x); h0[2] = bf_lo(t.y); h0[3] = bf_hi(t.y); h1[0] = bf_lo(t.z); h1[1] = bf_hi(t.z); h1[2] = bf_lo(t.w); h1[3] = bf_hi(t.w);
                    h0 = h0 * rs + acc[ai][bj][m][0]; h1 = h1 * rs + acc[ai][bj][m][1];
                    *(u32x4*)(Hb + off) = pack8(h0, h1);
                    ss += (h0[0] * h0[0] + h0[1] * h0[1]) + (h0[2] * h0[2] + h0[3] * h0[3]) + (h1[0] * h1[0] + h1[1] * h1[1]) + (h1[2] * h1[2] + h1[3] * h1[3]); }
                ss += __shfl_xor(ss, 16); ss += __shfl_xor(ss, 32);
                if (fq == 0) atomicAdd(rss + row, ss); }
    }
};
struct EpiGate {
    static constexpr bool PERM = true, AFTER_DRAIN = false; static constexpr int MID_T = 8;
    bf16_t* O; const bf16_t* Gt;
    __device__ __forceinline__ void mid(f32x4 (&acc)[2][2][4][2], const Unit& u, int wr, int wc, int fr, int fq) const {
        int rowb = u.pm * BM + wr * 64 + fr, colb = u.pn * BM + wc * 32 + 8 * fq;
        asm volatile("" : "+v"(rowb), "+v"(colb));
#pragma unroll
        for (int ai = 0; ai < 2; ++ai) {
            u32x4 ga[4][2], gb[4][2];
#pragma unroll
            for (int m = 0; m < 4; ++m)
#pragma unroll
                for (int bj = 0; bj < 2; ++bj) { const bf16_t* gp = Gt + (size_t)(rowb + ai * HALF + m * 16) * 2048 + colb + bj * HALF; ga[m][bj] = *(const u32x4*)gp; gb[m][bj] = *(const u32x4*)(gp + 1024); }
#pragma unroll
            for (int m = 0; m < 4; ++m)
#pragma unroll
                for (int bj = 0; bj < 2; ++bj) { const u32x4 a = ga[m][bj], b = gb[m][bj];
                    f32x4 r0, r1;
                    r0[0] = bf_lo(a.x) * __builtin_amdgcn_rcpf(fmaxf(bf_lo(b.x), 1e-30f)); r0[1] = bf_hi(a.x) * __builtin_amdgcn_rcpf(fmaxf(bf_hi(b.x), 1e-30f));
                    r0[2] = bf_lo(a.y) * __builtin_amdgcn_rcpf(fmaxf(bf_lo(b.y), 1e-30f)); r0[3] = bf_hi(a.y) * __builtin_amdgcn_rcpf(fmaxf(bf_hi(b.y), 1e-30f));
                    r1[0] = bf_lo(a.z) * __builtin_amdgcn_rcpf(fmaxf(bf_lo(b.z), 1e-30f)); r1[1] = bf_hi(a.z) * __builtin_amdgcn_rcpf(fmaxf(bf_hi(b.z), 1e-30f));
                    r1[2] = bf_lo(a.w) * __builtin_amdgcn_rcpf(fmaxf(bf_lo(b.w), 1e-30f)); r1[3] = bf_hi(a.w) * __builtin_amdgcn_rcpf(fmaxf(bf_hi(b.w), 1e-30f));
                    acc[ai][bj][m][0] *= r0; acc[ai][bj][m][1] *= r1; }
            asm volatile("" ::: "memory"); }
    }
    __device__ __forceinline__ void operator()(const f32x4 (&acc)[2][2][4][2], const Unit& u, int wr, int wc, int fr, int fq) const {
        const int rowb = u.pm * BM + wr * 64 + fr, colb = u.pn * BM + wc * 32 + 8 * fq;
        u32x4 pre[2][4][2];
#pragma unroll
        for (int ai = 0; ai < 2; ++ai)
#pragma unroll
            for (int m = 0; m < 4; ++m)
#pragma unroll
                for (int bj = 0; bj < 2; ++bj) pre[ai][m][bj] = *(const u32x4*)(Gt + (size_t)(rowb + ai * HALF + m * 16) * 2048 + 1024 + colb + bj * HALF);
        asm volatile("" ::: "memory");
#pragma unroll
        for (int ai = 0; ai < 2; ++ai)
#pragma unroll
            for (int m = 0; m < 4; ++m) { const int row = rowb + ai * HALF + m * 16;
#pragma unroll
                for (int bj = 0; bj < 2; ++bj) { const int col = colb + bj * HALF;
                    const u32x4 g = pre[ai][m][bj];
                    f32x4 v0 = acc[ai][bj][m][0], v1 = acc[ai][bj][m][1];
                    v0[0] *= bf_lo(g.x); v0[1] *= bf_hi(g.x); v0[2] *= bf_lo(g.y); v0[3] *= bf_hi(g.y); v1[0] *= bf_lo(g.z); v1[1] *= bf_hi(g.z); v1[2] *= bf_lo(g.w); v1[3] *= bf_hi(g.w);
                    *(u32x4*)(O + (size_t)row * D + col) = pack8(v0, v1); } }
    }
};
template <class Epi, class Sched, bool ALIGN_EPI = false, bool SP2 = false>
__device__ __forceinline__ void gemm_phase(PG8_LAS unsigned char* lds, const Gemm g, const Sched& S, const Epi& E) {
    int tid_ = threadIdx.x; asm volatile("" : "+v"(tid_));
    const int tid = tid_, wid = __builtin_amdgcn_readfirstlane(tid >> 6), lane = tid & 63, wr = wid >> 2, wc = wid & 3, fr = lane & 15, fq = lane >> 4;
    const int K = g.K, nt = K / BK;
    unsigned voffA[2], voffB[2];
#pragma unroll
    for (int i = 0; i < 2; ++i) { int R, C; stage_rc(tid * 16 + i * 8192, R, C); const int Rb = Epi::PERM ? ((R & ~31) + perm32(R & 31)) : R;
        voffA[i] = (unsigned)(R * g.lda + C) * 2u; voffB[i] = (unsigned)(Rb * g.ldb + C) * 2u; }
    const size_t kstep = (size_t)(BK * 2);
    const size_t hstepA = (size_t)HALF * g.lda * 2, hstepB = (size_t)HALF * g.ldb * 2;
    const size_t tstepA = 2 * hstepA, tstepB = 2 * hstepB;
    const unsigned ldsw = (unsigned)wid * 1024u;
    const int aoff = lds_byte(wr * 64 + fr, fq * 8), boff = lds_byte(wc * 32 + fr, fq * 8);
#define PG8_SA(b, h) (((b) * 2 + (h)) * HTB)
#define PG8_SB(b, h) ((4 + (b) * 2 + (h)) * HTB)
#define PG8_STAGE(bufoff, gbase, voff) do { _Pragma("unroll") for (int _i = 0; _i < 2; ++_i) \
        __builtin_amdgcn_global_load_lds((const unsigned*)((const char*)(gbase) + (voff)[_i]), (PG8_LAS unsigned*)(lds + (bufoff) + ldsw + _i * 8192), 16, 0, 0); } while (0)
#define PG8_LDA(dst, b, h) do { _Pragma("unroll") for (int m = 0; m < 4; ++m) _Pragma("unroll") for (int k = 0; k < 2; ++k) dst[m][k] = *(const PG8_LAS bf16x8*)(lds + PG8_SA(b, h) + aoff + m * 2048 + k * 1024); } while (0)
#define PG8_LDB(dst, b, h) do { _Pragma("unroll") for (int n = 0; n < 2; ++n) _Pragma("unroll") for (int k = 0; k < 2; ++k) dst[n][k] = *(const PG8_LAS bf16x8*)(lds + PG8_SB(b, h) + boff + n * 2048 + k * 1024); } while (0)
#define PG8_MMA(ai, bj, At, Bt) do { __builtin_amdgcn_s_setprio(1); _Pragma("unroll") for (int m = 0; m < 4; ++m) _Pragma("unroll") for (int n = 0; n < 2; ++n) _Pragma("unroll") for (int k = 0; k < 2; ++k) \
        acc[ai][bj][m][n] = __builtin_amdgcn_mfma_f32_16x16x32_bf16(Bt[n][k], At[m][k], acc[ai][bj][m][n], 0, 0, 0); __builtin_amdgcn_s_setprio(0); } while (0)
#define PG8_WAIT_V(n) asm volatile("s_waitcnt vmcnt(" #n ")" ::: "memory")
#define PG8_WAIT_L(n) asm volatile("s_waitcnt lgkmcnt(" #n ")" ::: "memory")
#define PG8_BAR __builtin_amdgcn_s_barrier()
#define PG8_SCHED __builtin_amdgcn_sched_barrier(0)
    Unit cur, nxt; int ui = 0;
    if (!S.next(0, cur)) return;
    f32x4 acc[2][2][4][2];
#pragma unroll
    for (int a = 0; a < 2; ++a)
#pragma unroll
        for (int b = 0; b < 2; ++b)
#pragma unroll
            for (int m = 0; m < 4; ++m)
#pragma unroll
                for (int n = 0; n < 2; ++n) acc[a][b][m][n] = (f32x4){0.f, 0.f, 0.f, 0.f};
    bf16x8 At[4][2], B0[2][2], B1[2][2];
    const char* cA = (const char*)g.A + (size_t)cur.g * g.sA * 2 + (size_t)cur.pm * tstepA; const char* cB = (const char*)g.Bt + (size_t)cur.g * g.sB * 2 + (size_t)cur.pn * tstepB;
    if constexpr (SP2) {
        PG8_STAGE(PG8_SB(0, 0), cB, voffB); PG8_STAGE(PG8_SB(0, 1), cB + hstepB, voffB); PG8_STAGE(PG8_SA(0, 0), cA, voffA); PG8_STAGE(PG8_SA(0, 1), cA + hstepA, voffA);
        if (wr == 1) PG8_BAR;
        PG8_WAIT_V(2); PG8_BAR;
        PG8_STAGE(PG8_SB(1, 0), cB + kstep, voffB); PG8_STAGE(PG8_SA(1, 0), cA + kstep, voffA); PG8_STAGE(PG8_SB(1, 1), cB + hstepB + kstep, voffB);
        PG8_WAIT_V(6); PG8_BAR;
    } else {
        PG8_STAGE(PG8_SB(0, 0), cB, voffB); PG8_STAGE(PG8_SA(0, 0), cA, voffA); PG8_STAGE(PG8_SB(0, 1), cB + hstepB, voffB); PG8_STAGE(PG8_SA(0, 1), cA + hstepA, voffA);
        if (wr == 1) PG8_BAR;
        PG8_WAIT_V(4); PG8_BAR;
        PG8_STAGE(PG8_SB(1, 0), cB + kstep, voffB); PG8_STAGE(PG8_SA(1, 0), cA + kstep, voffA); PG8_STAGE(PG8_SB(1, 1), cB + hstepB + kstep, voffB);
        PG8_WAIT_V(6); PG8_BAR;
    }
    for (;;) {
        const bool has_next = S.next(ui + 1, nxt);
        const char* nA = has_next ? (const char*)g.A + (size_t)nxt.g * g.sA * 2 + (size_t)nxt.pm * tstepA : cA; const char* nB = has_next ? (const char*)g.Bt + (size_t)nxt.g * g.sB * 2 + (size_t)nxt.pn * tstepB : cB;
        for (int t = 0; t < nt; t += 2) {
            const bool last = (t == nt - 2);
            const char* a1 = cA + (size_t)(t + 1) * kstep;
            const char* a2 = last ? nA : cA + (size_t)(t + 2) * kstep; const char* b2 = last ? nB : cB + (size_t)(t + 2) * kstep;
            const char* a3 = a2 + kstep; const char* b3 = b2 + kstep;
            if constexpr (Epi::MID_T >= 0) { if (t == Epi::MID_T) E.mid(acc, cur, wr, wc, fr, fq); }
            if constexpr (SP2) {
            PG8_LDB(B0, 0, 0); PG8_LDB(B1, 0, 1); PG8_SCHED; PG8_LDA(At, 0, 0); PG8_STAGE(PG8_SA(1, 1), a1 + hstepA, voffA);
            PG8_WAIT_V(8); PG8_WAIT_L(0); PG8_BAR; PG8_MMA(0, 0, At, B0); PG8_MMA(0, 1, At, B1); PG8_BAR; PG8_SCHED;
            PG8_LDA(At, 0, 1); PG8_STAGE(PG8_SB(0, 0), b2, voffB); PG8_STAGE(PG8_SB(0, 1), b2 + hstepB, voffB); PG8_STAGE(PG8_SA(0, 0), a2, voffA);
            PG8_WAIT_V(8); PG8_WAIT_L(0); PG8_BAR; PG8_MMA(1, 0, At, B0); PG8_MMA(1, 1, At, B1); PG8_BAR; PG8_SCHED;
            PG8_LDB(B0, 1, 0); PG8_LDB(B1, 1, 1); PG8_SCHED; PG8_LDA(At, 1, 0); PG8_STAGE(PG8_SA(0, 1), a2 + hstepA, voffA);
            PG8_WAIT_V(8); PG8_WAIT_L(0); PG8_BAR; PG8_MMA(0, 0, At, B0); PG8_MMA(0, 1, At, B1); PG8_BAR; PG8_SCHED;
            PG8_LDA(At, 1, 1); PG8_STAGE(PG8_SB(1, 0), b3, voffB); PG8_STAGE(PG8_SB(1, 1), b3 + hstepB, voffB); PG8_STAGE(PG8_SA(1, 0), a3, voffA);
            PG8_WAIT_V(8); PG8_WAIT_L(0); PG8_BAR; PG8_MMA(1, 0, At, B0); PG8_MMA(1, 1, At, B1); PG8_BAR; PG8_SCHED;
            } else {
            PG8_LDB(B0, 0, 0); PG8_SCHED; PG8_LDA(At, 0, 0); PG8_STAGE(PG8_SA(1, 1), a1 + hstepA, voffA);
            PG8_WAIT_L(8); PG8_BAR; PG8_WAIT_L(0); PG8_MMA(0, 0, At, B0); PG8_BAR; PG8_SCHED;
            PG8_LDB(B1, 0, 1); PG8_STAGE(PG8_SB(0, 0), b2, voffB);
            PG8_BAR; PG8_WAIT_L(0); PG8_MMA(0, 1, At, B1); PG8_BAR;
            PG8_LDA(At, 0, 1); PG8_STAGE(PG8_SA(0, 0), a2, voffA);
            PG8_BAR; PG8_WAIT_L(0); PG8_MMA(1, 0, At, B0); PG8_BAR; PG8_SCHED;
            PG8_STAGE(PG8_SB(0, 1), b2 + hstepB, voffB);
            PG8_WAIT_V(6); PG8_BAR; PG8_MMA(1, 1, At, B1); PG8_BAR;
            PG8_LDB(B0, 1, 0); PG8_SCHED; PG8_LDA(At, 1, 0); PG8_STAGE(PG8_SA(0, 1), a2 + hstepA, voffA);
            PG8_WAIT_L(8); PG8_BAR; PG8_WAIT_L(0); PG8_MMA(0, 0, At, B0); PG8_BAR; PG8_SCHED;
            PG8_LDB(B1, 1, 1); PG8_STAGE(PG8_SB(1, 0), b3, voffB);
            PG8_BAR; PG8_WAIT_L(0); PG8_MMA(0, 1, At, B1); PG8_BAR;
            PG8_LDA(At, 1, 1); PG8_STAGE(PG8_SA(1, 0), a3, voffA);
            PG8_BAR; PG8_WAIT_L(0); PG8_MMA(1, 0, At, B0); PG8_BAR; PG8_SCHED;
            PG8_STAGE(PG8_SB(1, 1), b3 + hstepB, voffB);
            PG8_WAIT_V(6); PG8_BAR; PG8_MMA(1, 1, At, B1); PG8_BAR;
            }
        }
        if constexpr (ALIGN_EPI) { if (wr == 0) PG8_BAR; }
        if constexpr (!Epi::AFTER_DRAIN) { E(acc, cur, wr, wc, fr, fq); }
        if (!has_next) break;
#pragma unroll
        for (int a = 0; a < 2; ++a)
#pragma unroll
            for (int b = 0; b < 2; ++b)
#pragma unroll
                for (int m = 0; m < 4; ++m)
#pragma unroll
                    for (int n = 0; n < 2; ++n) acc[a][b][m][n] = (f32x4){0.f, 0.f, 0.f, 0.f};
        cur = nxt; cA = nA; cB = nB; ++ui;
        if constexpr (ALIGN_EPI) { if (wr == 1) PG8_BAR; }
    }
    PG8_WAIT_V(0);
    if constexpr (!ALIGN_EPI) { if (wr == 0) PG8_BAR; }
    PG8_BAR;
    if constexpr (Epi::AFTER_DRAIN) { E.fused(acc, cur, wr, wc, fr, fq, lds, wid, lane); }
#undef PG8_SA
#undef PG8_SB
#undef PG8_STAGE
#undef PG8_LDA
#undef PG8_LDB
#undef PG8_MMA
#undef PG8_WAIT_V
#undef PG8_WAIT_L
#undef PG8_BAR
#undef PG8_SCHED
}
}
namespace attn_body {
using bf16=__hip_bfloat16;
using bf16x8=__attribute__((ext_vector_type(8)))short;
using s16x4=__attribute__((ext_vector_type(4)))short;
using f32x16=__attribute__((ext_vector_type(16)))float;
using u32x4=__attribute__((ext_vector_type(4)))unsigned;
constexpr int BATCH=8,NHEAD=16,SEQ=8192,D=64,DM=1536;
constexpr int KVP=256,KVROWS=SEQ+64,NTILES=KVROWS/64;
constexpr int NW=8,QBLK=32,QB=QBLK*NW,KVBLK=64,NQB=SEQ/QB;
constexpr int ATTN_PITCH=DM, ATTN_UNIT_ROWS=QB;
__device__ __forceinline__ int crow(int r,int hi){return (r&3)+8*(r>>2)+4*hi;}
#define SBAR() __builtin_amdgcn_sched_barrier(0)
constexpr int NSLOT=3, SLOTB=8192;
constexpr int LDS_K=0, LDS_V=NSLOT*SLOTB, LDS_WS=2*NSLOT*SLOTB, LDS_OST=LDS_WS+NW*64*4, LDS_BYTES=LDS_OST+NW*4096;
constexpr float C2=0.125f*1.4426950408889634f;
__device__ __forceinline__ void glds16(const void*gsrc,unsigned lds_dst){unsigned keep;
  asm volatile("s_mov_b32 %0, m0\n\ts_mov_b32 m0, %2\n\ts_nop 0\n\tglobal_load_lds_dwordx4 %1, off\n\ts_mov_b32 m0, %0":"=&s"(keep):"v"(gsrc),"s"(lds_dst):"memory");}
__device__ __forceinline__ float max3f(float a,float b,float c){float r;asm("v_max3_f32 %0, %1, %2, %3":"=v"(r):"v"(a),"v"(b),"v"(c));return r;}
__device__ __forceinline__ float max2f(float a,float b){float r;asm("v_max_f32_e32 %0, %1, %2":"=v"(r):"v"(a),"v"(b));return r;}
__device__ __forceinline__ float fadd_s(float a,float b){float r;asm("v_add_f32_e32 %0, %1, %2":"=v"(r):"v"(a),"v"(b));return r;}
__device__ __forceinline__ float fsub_s(float a,float b){float r;asm("v_sub_f32_e32 %0, %1, %2":"=v"(r):"v"(a),"v"(b));return r;}
typedef float f32x2_t __attribute__((ext_vector_type(2))); typedef __bf16 bf16x2_t __attribute__((ext_vector_type(2)));
__device__ __forceinline__ unsigned cvtpk_s(float lo,float hi){f32x2_t v={lo,hi};bf16x2_t b=__builtin_convertvector(v,bf16x2_t);return __builtin_bit_cast(unsigned,b);}
#define WAIT_BAR(N) asm volatile("s_waitcnt vmcnt(" #N ") lgkmcnt(0)\n\ts_barrier":::"memory")

__device__ __forceinline__ void qkt(f32x16&p0,f32x16&p1,const char*Kslot,const bf16x8*qr,const f32x16&negm,int r32,int hi){
  const char*kb=Kslot+hi*1024+r32*16;
  #pragma unroll
  for(int d0=0;d0<4;++d0){
    const bf16x8 b0=*reinterpret_cast<const bf16x8*>(kb+d0*2048);
    const bf16x8 b1=*reinterpret_cast<const bf16x8*>(kb+d0*2048+512);
    if(d0==0){p0=__builtin_amdgcn_mfma_f32_32x32x16_bf16(b0,qr[0],negm,0,0,0);p1=__builtin_amdgcn_mfma_f32_32x32x16_bf16(b1,qr[0],negm,0,0,0);}
    else{p0=__builtin_amdgcn_mfma_f32_32x32x16_bf16(b0,qr[d0],p0,0,0,0);p1=__builtin_amdgcn_mfma_f32_32x32x16_bf16(b1,qr[d0],p1,0,0,0);}}
}
typedef __attribute__((address_space(3))) const char* lds_cptr;
typedef short v4i16_t __attribute__((ext_vector_type(4)));
__device__ __forceinline__ void kload8(bf16x8*kf,lds_cptr kp){
  kf[0]=*(const __attribute__((address_space(3))) bf16x8*)(kp);      kf[1]=*(const __attribute__((address_space(3))) bf16x8*)(kp+512);
  kf[2]=*(const __attribute__((address_space(3))) bf16x8*)(kp+2048); kf[3]=*(const __attribute__((address_space(3))) bf16x8*)(kp+2560);
  kf[4]=*(const __attribute__((address_space(3))) bf16x8*)(kp+4096); kf[5]=*(const __attribute__((address_space(3))) bf16x8*)(kp+4608);
  kf[6]=*(const __attribute__((address_space(3))) bf16x8*)(kp+6144); kf[7]=*(const __attribute__((address_space(3))) bf16x8*)(kp+6656);
}
__device__ __forceinline__ void kload2(bf16x8*kf,lds_cptr kp,int j){ kf[2*j]=*(const __attribute__((address_space(3))) bf16x8*)(kp+j*2048); kf[2*j+1]=*(const __attribute__((address_space(3))) bf16x8*)(kp+j*2048+512); }
__device__ __forceinline__ s16x4 vtr(lds_cptr p){ return __builtin_bit_cast(s16x4,__builtin_amdgcn_ds_read_tr16_b64_v4i16((__attribute__((address_space(3))) v4i16_t*)p)); }
__device__ __forceinline__ float rowmax(const f32x16&p0,const f32x16&p1){
  float a=max3f(p0[0],p0[1],p1[0]),b=max3f(p0[2],p0[3],p1[1]);a=max3f(a,p1[2],p1[3]);
  #pragma unroll
  for(int r=4;r<16;r+=4){a=max3f(a,p0[r],p0[r+1]);b=max3f(b,p0[r+2],p0[r+3]);a=max3f(a,p1[r],p1[r+1]);b=max3f(b,p1[r+2],p1[r+3]);}
  const float m=max2f(a,b);
  auto rr=__builtin_amdgcn_permlane32_swap(__float_as_uint(m),__float_as_uint(m),false,false);
  return max2f(__uint_as_float(rr[0]),__uint_as_float(rr[1]));
}
__device__ __forceinline__ void pv(f32x16*o,int vb,bf16x8 pa0,bf16x8 pa1,bf16x8 pa2,bf16x8 pa3){
  #pragma unroll
  for(int d0=0;d0<2;++d0){s16x4 lo[4],hi[4];
    #pragma unroll
    for(int ks=0;ks<4;++ks){
      asm volatile("ds_read_b64_tr_b16 %0,%1 offset:%c2":"=&v"(lo[ks]):"v"(vb),"i"(d0*4096+ks*1024):"memory");
      asm volatile("ds_read_b64_tr_b16 %0,%1 offset:%c2":"=&v"(hi[ks]):"v"(vb),"i"(d0*4096+ks*1024+512):"memory");}
    asm volatile("s_waitcnt lgkmcnt(0)":::"memory");SBAR();
    #define PK(k) (bf16x8){lo[k][0],lo[k][1],lo[k][2],lo[k][3],hi[k][0],hi[k][1],hi[k][2],hi[k][3]}
    o[d0]=__builtin_amdgcn_mfma_f32_32x32x16_bf16(pa0,PK(0),o[d0],0,0,0);
    o[d0]=__builtin_amdgcn_mfma_f32_32x32x16_bf16(pa1,PK(1),o[d0],0,0,0);
    o[d0]=__builtin_amdgcn_mfma_f32_32x32x16_bf16(pa2,PK(2),o[d0],0,0,0);
    o[d0]=__builtin_amdgcn_mfma_f32_32x32x16_bf16(pa3,PK(3),o[d0],0,0,0);
    #undef PK
  }
}

#ifndef ATTN_STORE16
#define ATTN_STORE16(p,v) (*(u32x4*)(p)=(v))
#endif
template<int THRL> __device__ __forceinline__ void attn_unit(int b,int h,int qb,const bf16*Q,const bf16*__restrict__ K,const bf16*__restrict__ V,bf16*O,char*shm){
  int tid_=threadIdx.x; asm volatile("":"+v"(tid_)); const int tid=tid_,lane=tid&63,r32=lane&31,hi=lane>>5; const int wid=__builtin_amdgcn_readfirstlane(tid>>6);
  const long rowbase=(long)b*SEQ,rowbaseK=(long)b*KVROWS; const int q0=qb*QB,kvh=h>>2;
  const bf16*Qw=Q+(rowbase+q0+wid*QBLK)*DM+h*D;
  const bf16*Kh=K+rowbaseK*KVP+kvh*D,*Vh=V+rowbaseK*KVP+kvh*D;
  const unsigned lds0=(unsigned)(uintptr_t)shm;
  float*wsf=(float*)(shm+LDS_WS)+wid*64;
  const bf16*ksrc=Kh+(long)lane*KVP+wid*8;
  const bf16*vsrc=Vh+(long)(16*(wid&3)+(lane>>2))*KVP+(wid>>2)*32+(lane&3)*8;
  const unsigned kdst=lds0+LDS_K+wid*1024, vdst=lds0+LDS_V+wid*1024;
  #define DMA_K(t,slot) glds16(ksrc+(long)(t)*KVBLK*KVP,(unsigned)__builtin_amdgcn_readfirstlane(kdst+(slot)))
  #define DMA_V(t,slot) glds16(vsrc+(long)(t)*KVBLK*KVP,(unsigned)__builtin_amdgcn_readfirstlane(vdst+(slot)))
  const int vb0=(int)(lds0+LDS_V)+((lane>>4)&1)*32+(lane&3)*8+(4*hi+((lane&15)>>2))*64;
  const char*Kbase=shm+LDS_K; bf16x8 kf[8];
  const lds_cptr shm3=(lds_cptr)shm; const lds_cptr kp0=shm3+LDS_K+hi*1024+r32*16; const lds_cptr vp0=shm3+LDS_V+((lane>>4)&1)*32+(lane&3)*8+(4*hi+((lane&15)>>2))*64;
  constexpr int NT=NTILES;
  DMA_K(0,0);DMA_V(0,0);DMA_K(1,SLOTB);
  bf16x8 qr[4];
  #pragma unroll
  for(int d0=0;d0<4;++d0)qr[d0]=*reinterpret_cast<const bf16x8*>(&Qw[(long)r32*DM+d0*16+hi*8]);
  float l_reg=0.f;f32x16 o[2];o[0]=f32x16{};o[1]=f32x16{};const f32x16 negm=f32x16{};
  #define CMASK(P0,P1,t) do{}while(0)
  #define START(P0,P1) do{ _Pragma("unroll") for(int r=0;r<16;++r)P0[r]=__builtin_amdgcn_exp2f(P0[r]); }while(0)
  #define RESC() do{}while(0)
  f32x16 pA0,pA1,pB0,pB1;
  int sl_prev=0,sl_cur=0,sl_next=SLOTB;
  #define ROT() do{sl_prev=sl_cur;sl_cur=sl_next;sl_next=(sl_next==(NSLOT-1)*SLOTB)?0:sl_next+SLOTB;}while(0)
  DMA_K(2,2*SLOTB);
  WAIT_BAR(3);
  qkt(pA0,pA1,Kbase,qr,negm,r32,hi);asm volatile("s_nop 15\n\ts_nop 7":"+v"(pA0),"+v"(pA1));CMASK(pA0,pA1,0);
  START(pA0,pA1);
  _Pragma("unroll") for(int r=0;r<16;++r)pA1[r]=__builtin_amdgcn_exp2f(pA1[r]);
  WAIT_BAR(0);
  DMA_K(3,0);DMA_V(1,SLOTB);
  ROT();
  kload8(kf,kp0+sl_cur);
  WAIT_BAR(2);
  s16x4 vlo[8],vhi[8]; u32x4 pw0,pw1,pw2,pw3;
  #define PKW(P,B) cvtpk_s(P[B],P[B+1])
  #define PAF(k) __builtin_bit_cast(bf16x8,pw##k)
  #define VFR(i) (bf16x8){vlo[i][0],vlo[i][1],vlo[i][2],vlo[i][3],vhi[i][0],vhi[i][1],vhi[i][2],vhi[i][3]}
  #define PIN(x) asm volatile("":"+v"(x))
  #define MX3(a,b,c) __builtin_fmaxf(__builtin_fmaxf((a),(b)),(c))
  #define GAPA(MF,A0,A1,A2,A3,W0,W1,PW) do{ MF; sacc+=A0; sacc+=A1; sacc+=A2; sacc+=A3; PIN(sacc); W0; W1; PIN(PW); SBAR(); }while(0)
  #define EX(v) __builtin_amdgcn_exp2f(v)
  #define GAPB(MF,X,B) do{ MF; X[B]=EX(X[B]); X[B+1]=EX(X[B+1]); X[B+2]=EX(X[B+2]); X[B+3]=EX(X[B+3]); PIN(X); SBAR(); }while(0)
  #define VRD(i) do{ vlo[i]=vtr(vp_+(((i)>>2)*4096+((i)&3)*1024)); vhi[i]=vtr(vp_+(((i)>>2)*4096+((i)&3)*1024+512)); }while(0)
  #define KRD(G,j) do{ if(G){ kload2(kf,kp0+sl_next,j); SBAR(); } }while(0)
  #define STEP(C0,C1,P0,P1,t,GK,GV,GL) do{ SBAR(); \
    if(wid<4){ if(GK){DMA_K((t)+3,sl_cur);} if(GV){DMA_V((t)+1,sl_next);} }     \
    const lds_cptr vp_=vp0+sl_prev; \
    VRD(0); SBAR(); float sacc=(P0[0]+P0[1]); \
    GAPA(C0=__builtin_amdgcn_mfma_f32_32x32x16_bf16(kf[0],qr[0],negm,0,0,0), P0[2],P0[3],P0[4],P0[5],     pw0[0]=PKW(P0,0), pw0[1]=PKW(P0,2), pw0); \
    VRD(4); SBAR(); GAPA(C1=__builtin_amdgcn_mfma_f32_32x32x16_bf16(kf[1],qr[0],negm,0,0,0), P0[6],P0[7],P0[8],P0[9],     pw0[2]=PKW(P0,4), pw0[3]=PKW(P0,6), pw0); \
    VRD(1); SBAR(); GAPA(C0=__builtin_amdgcn_mfma_f32_32x32x16_bf16(kf[2],qr[1],C0,0,0,0),   P0[10],P0[11],P0[12],P0[13], pw1[0]=PKW(P0,8), pw1[1]=PKW(P0,10), pw1); \
    VRD(5); SBAR(); GAPA(C1=__builtin_amdgcn_mfma_f32_32x32x16_bf16(kf[3],qr[1],C1,0,0,0),   P0[14],P0[15],P1[0],P1[1],   pw1[2]=PKW(P0,12),pw1[3]=PKW(P0,14), pw1); \
    VRD(2); SBAR(); GAPA(C0=__builtin_amdgcn_mfma_f32_32x32x16_bf16(kf[4],qr[2],C0,0,0,0),   P1[2],P1[3],P1[4],P1[5],     pw2[0]=PKW(P1,0), pw2[1]=PKW(P1,2), pw2); \
    VRD(6); SBAR(); GAPA(C1=__builtin_amdgcn_mfma_f32_32x32x16_bf16(kf[5],qr[2],C1,0,0,0),   P1[6],P1[7],P1[8],P1[9],     pw2[2]=PKW(P1,4), pw2[3]=PKW(P1,6), pw2); \
    VRD(3); SBAR(); GAPA(C0=__builtin_amdgcn_mfma_f32_32x32x16_bf16(kf[6],qr[3],C0,0,0,0),   P1[10],P1[11],P1[12],P1[13], pw3[0]=PKW(P1,8), pw3[1]=PKW(P1,10), pw3); \
    VRD(7); SBAR(); GAPA(C1=__builtin_amdgcn_mfma_f32_32x32x16_bf16(kf[7],qr[3],C1,0,0,0),   P1[14],P1[15],0.f,0.f,       pw3[2]=PKW(P1,12),pw3[3]=PKW(P1,14), pw3); \
    l_reg+=sacc; \
    if(wid>=4){ if(GK){DMA_K((t)+3,sl_cur);} if(GV){DMA_V((t)+1,sl_next);} } \
    CMASK(C0,C1,t); \
    SBAR(); \
    GAPB(o[0]=__builtin_amdgcn_mfma_f32_32x32x16_bf16(PAF(0),VFR(0),o[0],0,0,0), C0,0); \
    GAPB(o[1]=__builtin_amdgcn_mfma_f32_32x32x16_bf16(PAF(0),VFR(4),o[1],0,0,0), C0,4); \
    KRD(GL,0); GAPB(o[0]=__builtin_amdgcn_mfma_f32_32x32x16_bf16(PAF(1),VFR(1),o[0],0,0,0), C0,8); \
    KRD(GL,1); GAPB(o[1]=__builtin_amdgcn_mfma_f32_32x32x16_bf16(PAF(1),VFR(5),o[1],0,0,0), C0,12); \
    KRD(GL,2); GAPB(o[0]=__builtin_amdgcn_mfma_f32_32x32x16_bf16(PAF(2),VFR(2),o[0],0,0,0), C1,0); \
    KRD(GL,3); GAPB(o[1]=__builtin_amdgcn_mfma_f32_32x32x16_bf16(PAF(2),VFR(6),o[1],0,0,0), C1,4); \
    GAPB(o[0]=__builtin_amdgcn_mfma_f32_32x32x16_bf16(PAF(3),VFR(3),o[0],0,0,0), C1,8); \
    GAPB(o[1]=__builtin_amdgcn_mfma_f32_32x32x16_bf16(PAF(3),VFR(7),o[1],0,0,0), C1,12); \
    }while(0)
  int t=1;
  #undef CMASK
  #define CMASK(P0,P1,t) do{}while(0)
  for(;t+5<NT;t+=2){
    STEP(pB0,pB1,pA0,pA1,t,true,true,true);     WAIT_BAR(2); RESC(); ROT();
    STEP(pA0,pA1,pB0,pB1,t+1,true,true,true);   WAIT_BAR(2); RESC(); ROT();
  }
  #undef CMASK
  #define CMASK(P0,P1,t) do{ if((t)==NT-1){ _Pragma("unroll") for(int r_=8;r_<16;++r_)P0[r_]=-INFINITY; _Pragma("unroll") for(int r_=0;r_<16;++r_)P1[r_]=-INFINITY; } }while(0)
  #define ENDW(tt) do{ if((tt)+3<NT){WAIT_BAR(2);} else if((tt)+2<NT){WAIT_BAR(1);} else {WAIT_BAR(0);} }while(0)
  for(;t+1<NT;t+=2){
    STEP(pB0,pB1,pA0,pA1,t,(t+3<NT),(t+1<NT),(t+1<NT));       ENDW(t);   RESC(); ROT();
    STEP(pA0,pA1,pB0,pB1,t+1,(t+4<NT),(t+2<NT),(t+2<NT));     ENDW(t+1); RESC(); ROT();
  }
  static_assert((NT&1)==1&&NT>=7,"odd tile count: the band loop ends on its second step (tile NT-1 in buffer A)");
  { float sacc=pA0[0]+pA0[1]; _Pragma("unroll") for(int r=2;r<16;++r)sacc+=pA0[r]; _Pragma("unroll") for(int r=0;r<16;++r)sacc+=pA1[r]; l_reg+=sacc;
    pw0=(u32x4){PKW(pA0,0),PKW(pA0,2),PKW(pA0,4),PKW(pA0,6)};pw1=(u32x4){PKW(pA0,8),PKW(pA0,10),PKW(pA0,12),PKW(pA0,14)};pw2=(u32x4){PKW(pA1,0),PKW(pA1,2),PKW(pA1,4),PKW(pA1,6)};pw3=(u32x4){PKW(pA1,8),PKW(pA1,10),PKW(pA1,12),PKW(pA1,14)};
    SBAR(); pv(o,vb0+sl_prev,PAF(0),PAF(1),PAF(2),PAF(3)); }
  #undef PKW
  #undef PAF
  #undef VFR
  #undef PIN
  #undef MX3
  #undef GAPA
  #undef GAPB
  #undef EX
  #undef VRD
  #undef KRD
  #undef STEP
  #undef ENDW
  {auto rr=__builtin_amdgcn_permlane32_swap(__float_as_uint(l_reg),__float_as_uint(l_reg),false,false);l_reg=__uint_as_float(rr[0])+__uint_as_float(rr[1]);}
  if(hi==0)wsf[32+r32]=l_reg;asm volatile("s_waitcnt lgkmcnt(0)":::"memory");
  float rli[16];
  #pragma unroll
  for(int r=0;r<16;++r)rli[r]=__builtin_amdgcn_rcpf(wsf[32+crow(r,hi)]);
  bf16*Ow=O+(rowbase+q0+wid*QBLK)*DM+h*D;
  { bf16*stg=(bf16*)(shm+LDS_OST)+wid*2048;
    #pragma unroll
    for(int r=0;r<16;++r){const int orow=crow(r,hi);
      #pragma unroll
      for(int d0=0;d0<2;++d0)stg[orow*64+d0*32+r32]=__float2bfloat16(o[d0][r]*rli[r]);}
    asm volatile("s_waitcnt lgkmcnt(0)":::"memory");
    #pragma unroll
    for(int i=0;i<4;++i){const int row=i*8+(lane>>3),ch=lane&7; const u32x4 v=*(const u32x4*)(stg+row*64+ch*8); ATTN_STORE16(Ow+(long)row*DM+ch*8,v);} }
  asm volatile("s_waitcnt lgkmcnt(0)\n\ts_barrier":::"memory");
  #undef DMA_K
  #undef DMA_V
  #undef CMASK
  #undef START
  #undef RESC
  #undef ROT
}
constexpr int ATTN_LDS_BYTES=LDS_BYTES;
struct AttnTensors { const bf16* Q; const bf16* K; const bf16* V; bf16* O; };
struct AttnUnit { int bh; int qb; };
struct StaticOrder {
  int x,j;
  __device__ __forceinline__ explicit StaticOrder(int grid,int block):x(block&7),j(block>>3){}
  __device__ __forceinline__ bool next(int i,AttnUnit&u)const{ if(i>=16)return false; const int pair=x*4+(i>>2); u.bh=(pair>>2)*NHEAD+(pair&3)*4+(i&3); u.qb=j; return true; }
  __device__ __forceinline__ void a_ready(const AttnUnit&)const{}
  __device__ __forceinline__ void done(const AttnUnit&)const{}
};
template<class Sched,int THRL=8> __device__ __forceinline__ void attn_phase(char*lds,const AttnTensors&T,const Sched&S){
  AttnUnit u;
  for(int i=0;S.next(i,u);++i){ S.a_ready(u); attn_unit<THRL>(u.bh/NHEAD,u.bh%NHEAD,u.qb,T.Q,T.K,T.V,T.O,lds); S.done(u); }
}
#undef SBAR
#undef WAIT_BAR
}
constexpr size_t MiB = 1u << 20, KiB = 1024;
constexpr size_t WS_RSS1 = 0, WS_RSS2 = 256 * KiB, WS_ROPE = 512 * KiB, WS_UMETA = 544 * KiB, WS_LAM1 = 576 * KiB, WS_LAM32 = 608 * KiB, WS_XNRM = 704 * KiB, WS_BBW = 1 * MiB;
constexpr size_t WS_BAR = 640 * KiB;
constexpr size_t WS_WIN = 2 * MiB, WS_WGLU = 10 * MiB, WS_PCAT = 11 * MiB, WS_WOUT = 14 * MiB, WS_W1 = 16 * MiB, WS_W2 = 24 * MiB;
constexpr size_t WS_MCAT = 32 * MiB, WS_MSTATE = 56 * MiB;
constexpr size_t WS_R1 = 64 * MiB;
constexpr size_t WS_ACAT = 192 * MiB, WS_S = 288 * MiB, WS_YQO = 352 * MiB, WS_K = 544 * MiB, WS_V = 577 * MiB, WS_Z = 610 * MiB;
constexpr size_t WS_MERGED = 192 * MiB;
constexpr size_t WS_HID = 192 * MiB;
constexpr size_t WS_GATES = 704 * MiB, WS_END = 960 * MiB;
static_assert(WS_ACAT + (size_t)NGRP * CROWS * KCAT * 2 <= WS_S && WS_S + (size_t)NGRP * CROWS * 256 * 4 <= WS_YQO && WS_YQO + (size_t)M * QP * 2 <= WS_K && WS_K + (size_t)BATCH * KVR * 256 * 2 <= WS_V &&
              WS_V + (size_t)BATCH * KVR * 256 * 2 <= WS_Z && WS_Z + (size_t)M * SSMW * 2 <= WS_GATES && WS_HID + (size_t)M * FF * 2 <= WS_GATES &&
              WS_GATES + (size_t)M * 2048 * 2 <= WS_END && WS_MCAT + (size_t)NGRP * 512 * KCAT * 2 <= WS_MSTATE && WS_MSTATE + (size_t)NGRP * 256 * 512 * 2 <= WS_R1 && WS_R1 + (size_t)M * D * 2 <= WS_ACAT &&
              WS_PCAT + (size_t)D * QP * 2 <= WS_WOUT, "d_ws map");

constexpr int LDS_BYTES = 147456;
#define LAS __attribute__((address_space(3)))
typedef unsigned short bf16;
typedef unsigned v4u __attribute__((ext_vector_type(4)));
typedef unsigned v2u __attribute__((ext_vector_type(2)));
typedef float f32x4 __attribute__((ext_vector_type(4)));
__device__ __forceinline__ unsigned f2bf(float f) { unsigned u = __builtin_bit_cast(unsigned, f); return (u + 0x7fffu + ((u >> 16) & 1u)) >> 16; }
__device__ __forceinline__ unsigned pk2(float lo, float hi) { return f2bf(lo) | (f2bf(hi) << 16); }
__device__ __forceinline__ float wave_sum(float v) {
#pragma unroll
    for (int o = 1; o < 64; o <<= 1) v += __shfl_xor(v, o);
    return v;
}
__device__ __forceinline__ double dexp_(double x) {
    const double y = x * (1.0 / 16.0);
    double p = 1.0 + y * (1.0 + y * (0.5 + y * (1.0 / 6 + y * (1.0 / 24 + y * (1.0 / 120 + y * (1.0 / 720 + y * (1.0 / 5040 + y * (1.0 / 40320 + y * (1.0 / 362880 + y * (1.0 / 3628800 + y * (1.0 / 39916800 + y * (1.0 / 479001600))))))))))));
    p *= p; p *= p; p *= p; p *= p; return p;
}
__device__ __forceinline__ void dsincos_(double a, double& s, double& c) {
    const double q = __builtin_rint(a * 0.63661977236758134308);
    double r = __builtin_fma(-q, 1.57079632679489655800, a); r = __builtin_fma(-q, 6.12323399573676603587e-17, r);
    const double r2 = r * r;
    const double sp = r * (1.0 + r2 * (-1.0 / 6 + r2 * (1.0 / 120 + r2 * (-1.0 / 5040 + r2 * (1.0 / 362880 + r2 * (-1.0 / 39916800 + r2 * (1.0 / 6227020800.0)))))));
    const double cp = 1.0 + r2 * (-0.5 + r2 * (1.0 / 24 + r2 * (-1.0 / 720 + r2 * (1.0 / 40320 + r2 * (-1.0 / 3628800 + r2 * (1.0 / 479001600 + r2 * (-1.0 / 87178291200.0)))))));
    const int qi = ((int)q) & 3;
    s = (qi == 0) ? sp : (qi == 1) ? cp : (qi == 2) ? -sp : -cp;
    c = (qi == 0) ? cp : (qi == 1) ? -sp : (qi == 2) ? -cp : sp;
}

__device__ __forceinline__ void p0_transpose_item(const float* W, int K, int N, bf16* WT, int ldw, int koff, const float* kscale, bool relabel, LAS float* scr, int item, int lane) {
    const int nblk = N / 32, kb = item / nblk, nb = item % nblk, k0 = 64 * kb, n0 = 32 * nb;
#pragma unroll 8
    for (int i = 0; i < 32; ++i) { const int kk = 2 * i + (lane >> 5); float w = W[(size_t)(k0 + kk) * N + n0 + (lane & 31)]; if (kscale) w *= kscale[k0 + kk]; scr[kk * 33 + (lane & 31)] = w; }
    asm volatile("s_waitcnt lgkmcnt(0)" ::: "memory");
    const int drow0 = relabel ? (n0 & ~255) + 128 * ((n0 >> 5) & 1) + 32 * ((n0 >> 6) & 3) : n0;
    const int c = lane & 7;
#pragma unroll
    for (int j = 0; j < 4; ++j) { const int n = (lane >> 3) + 8 * j; const LAS float* s = scr + (8 * c) * 33 + n;
        v4u o; o.x = pk2(s[0 * 33], s[1 * 33]); o.y = pk2(s[2 * 33], s[3 * 33]); o.z = pk2(s[4 * 33], s[5 * 33]); o.w = pk2(s[6 * 33], s[7 * 33]);
        *(v4u*)(WT + (size_t)(drow0 + n) * ldw + koff + k0 + 8 * c) = o; }
    asm volatile("s_waitcnt lgkmcnt(0)" ::: "memory");
}

__device__ __forceinline__ void p0_ssm_setup(LAS float* Lf, int g, int tid, const float* are, const float* aim, const float* logdt, const float* bre, const float* bim,
                                             const float* cre, const float* cim, const float* dvec, bf16* Mcat, bf16* Mstate, float* lam1, float* lam32, float* BbW) {
    LAS float* pwr = Lf;
    LAS float* pwi = Lf + 4224;
    LAS float* Bbr = Lf + 8448;
    LAS float* Bbi = Lf + 10496;
    LAS float* Cr = Lf + 12544;
    LAS float* Ci = Lf + 14592;
    LAS float* Kt = Lf + 16640;
    if (tid < 128) {
        const int d = tid >> 6, n = tid & 63, pi = (d * NGRP + g) * NST + n;
        const double dt = dexp_((double)logdt[d * NGRP + g]);
        const double lre = fmin((double)are[pi], (double)(-1e-4f)), lim = (double)aim[pi];
        const double xr = lre * dt, xi = lim * dt;
        for (int k = 0; k <= 32; ++k) { double s, c; dsincos_(xi * k, s, c); const double mg = dexp_(xr * k); pwr[(d * 33 + k) * 64 + n] = (float)(mg * c); pwi[(d * 33 + k) * 64 + n] = (float)(mg * s); }
        double s1, c1; dsincos_(xi, s1, c1); const double mg1 = dexp_(xr);
        const double nr = mg1 * c1 - 1.0, ni = mg1 * s1, den = lre * lre + lim * lim;
        const double fre = (nr * lre + ni * lim) / den, fim = (ni * lre - nr * lim) / den;
        for (int p = 0; p < GP; ++p) { const double br = bre[(size_t)pi * GP + p], bi = bim[(size_t)pi * GP + p];
            const float vr = (float)(fre * br - fim * bi), vi = (float)(fre * bi + fim * br);
            Bbr[(d * 64 + n) * 16 + p] = vr; Bbi[(d * 64 + n) * 16 + p] = vi;
            BbW[(((size_t)(g * 2 + d) * 64 + n) * 16 + p) * 2] = vr; BbW[(((size_t)(g * 2 + d) * 64 + n) * 16 + p) * 2 + 1] = vi; }
        lam1[((g * 2 + d) * 64 + n) * 2] = (float)(mg1 * c1); lam1[((g * 2 + d) * 64 + n) * 2 + 1] = (float)(mg1 * s1);
        { double s, c; dsincos_(xi * 32, s, c); const double mg = dexp_(xr * 32); lam32[((g * 2 + d) * 64 + n) * 2] = (float)(mg * c); lam32[((g * 2 + d) * 64 + n) * 2 + 1] = (float)(mg * s); }
    } else {
        for (int e = tid - 128; e < 4096; e += 384) { const int which = e >> 11, idx = e & 2047, d = idx >> 10, pn_ = idx & 1023;
            const float v = (which ? cim : cre)[(size_t)(d * NGRP + g) * 1024 + pn_];
            if (which) Ci[idx] = v; else Cr[idx] = v; }
    }
    __syncthreads();
    for (int it = 0; it < 2; ++it) { const int combo = tid + 512 * it, d = combo >> 9, k = (combo >> 4) & 31, p = combo & 15;
        float acc[16];
#pragma unroll
        for (int q = 0; q < 16; ++q) acc[q] = 0.f;
        for (int n = 0; n < 64; ++n) { const float pr = pwr[(d * 33 + k) * 64 + n], pi_ = pwi[(d * 33 + k) * 64 + n], cr = Cr[(d * 16 + p) * 64 + n], ci = Ci[(d * 16 + p) * 64 + n];
            const float cwr = cr * pr - ci * pi_, cwi = cr * pi_ + ci * pr;
#pragma unroll
            for (int q = 0; q < 16; ++q) acc[q] += cwr * Bbr[(d * 64 + n) * 16 + q] - cwi * Bbi[(d * 64 + n) * 16 + q]; }
#pragma unroll
        for (int q = 0; q < 16; ++q) Kt[(d * 32 + k) * 256 + p * 16 + q] = acc[q]; }
    __syncthreads();
    for (int it = 0; it < 64; ++it) { const int chunk = tid + 512 * it, row = chunk >> 6, cc = (chunk & 63) * 8, i = row >> 4, p = row & 15, s = cc >> 4, p0 = cc & 15;
        const int lag = (s < i) ? (i - s) : (32 + s - i); const bool dg = (s == i);
        const float dd = dg ? dvec[g * GP + p] : 0.f;
        float v[8];
#pragma unroll
        for (int e = 0; e < 8; ++e) { const float a = Kt[lag * 256 + p * 16 + p0 + e], b = Kt[p * 16 + p0 + e]; v[e] = a + (dg ? b : 0.f) + ((p0 + e) == p ? dd : 0.f); }
        v4u o; o.x = pk2(v[0], v[1]); o.y = pk2(v[2], v[3]); o.z = pk2(v[4], v[5]); o.w = pk2(v[6], v[7]);
        *(v4u*)(Mcat + ((size_t)g * 512 + row) * KCAT + cc) = o; }
    for (int it = 0; it < 32; ++it) { const int chunk = tid + 512 * it, row = chunk >> 5, col = (chunk & 31) * 8, i = row >> 4, p = row & 15, d = col >> 7, reim = (col >> 6) & 1, n0 = col & 63, ex = d ? (32 - i) : (i + 1);
        float v[8];
#pragma unroll
        for (int e = 0; e < 8; ++e) { const int n = n0 + e; const float cr = Cr[(d * 16 + p) * 64 + n], ci = Ci[(d * 16 + p) * 64 + n], pr = pwr[(d * 33 + ex) * 64 + n], pi_ = pwi[(d * 33 + ex) * 64 + n];
            v[e] = reim ? -(cr * pi_ + ci * pr) : (cr * pr - ci * pi_); }
        v4u o; o.x = pk2(v[0], v[1]); o.y = pk2(v[2], v[3]); o.z = pk2(v[4], v[5]); o.w = pk2(v[6], v[7]);
        *(v4u*)(Mcat + ((size_t)g * 512 + row) * KCAT + 512 + col) = o; }
    for (int it = 0; it < 32; ++it) { const int chunk = tid + 512 * it, row = chunk >> 6, cc = (chunk & 63) * 8, d = row >> 7, reim = (row >> 6) & 1, n = row & 63, s = cc >> 4, p0 = cc & 15, ex = d ? s : (31 - s);
        const float pr = pwr[(d * 33 + ex) * 64 + n], pi_ = pwi[(d * 33 + ex) * 64 + n];
        float v[8];
#pragma unroll
        for (int e = 0; e < 8; ++e) { const float br = Bbr[(d * 64 + n) * 16 + p0 + e], bi = Bbi[(d * 64 + n) * 16 + p0 + e]; v[e] = reim ? (pr * bi + pi_ * br) : (pr * br - pi_ * bi); }
        v4u o; o.x = pk2(v[0], v[1]); o.y = pk2(v[2], v[3]); o.z = pk2(v[4], v[5]); o.w = pk2(v[6], v[7]);
        *(v4u*)(Mstate + ((size_t)g * 256 + row) * 512 + cc) = o; }
    __syncthreads();
}

__device__ __forceinline__ void p0_meta_item(LAS float* Lf, int it, int tid, int lane, int wave, const float* meta, const float* gmix, const float* Win, const float* kg, float* umeta, bf16* Kb, bf16* Vb) {
    LAS float* hm = Lf;
    LAS float* red = Lf + 16384;
    LAS float* res = Lf + 24576;
    const int col0 = it < 8 ? 64 * it : (it < 12 ? 1536 + 64 * (it - 8) : 1792 + 64 * (it - 12));
    for (int rr = 0; rr < 2; ++rr) { const int r = 2 * wave + rr; float v[16]; float ss = 0.f;
#pragma unroll
        for (int j = 0; j < 16; ++j) { v[j] = meta[r * D + 64 * j + lane]; ss += v[j] * v[j]; }
        const float rinv = 1.0f / sqrtf(wave_sum(ss) * (1.0f / D) + NORM_EPS);
#pragma unroll
        for (int j = 0; j < 16; ++j) hm[r * D + 64 * j + lane] = v[j] * rinv * gmix[64 * j + lane]; }
    __syncthreads();
    { const int cl = tid & 63, ks = tid >> 6; float acc[16];
#pragma unroll
        for (int r = 0; r < 16; ++r) acc[r] = 0.f;
#pragma unroll 4
        for (int kk = 0; kk < 128; ++kk) { const int k = ks * 128 + kk; const float w = Win[(size_t)k * INW + col0 + cl];
#pragma unroll
            for (int r = 0; r < 16; ++r) acc[r] += hm[r * D + k] * w; }
#pragma unroll
        for (int r = 0; r < 16; ++r) red[(ks * 16 + r) * 64 + cl] = acc[r]; }
    __syncthreads();
    for (int q = 0; q < 2; ++q) { const int o = tid + 512 * q, r = o >> 6, c = o & 63; float s = 0.f;
#pragma unroll
        for (int ks = 0; ks < 8; ++ks) s += red[(ks * 16 + r) * 64 + c];
        res[o] = s; if (it < 8) umeta[r * SSMW + col0 + c] = s; }
    __syncthreads();
    if (it >= 8) { const int head = (it - 8) & 3; const bool isk = it < 12;
        for (int rr = 0; rr < 2; ++rr) { const int r = 2 * wave + rr; float v = res[r * 64 + lane];
            if (isk) { const float ss = wave_sum(v * v); v = v * (1.0f / sqrtf(ss * (1.0f / 64.0f) + NORM_EPS)) * kg[lane]; }
            const bf16 o = (bf16)f2bf(v); bf16* T = isk ? Kb : Vb;
            for (int b = 0; b < BATCH; ++b) T[((size_t)b * KVR + SEQ + r) * 256 + head * 64 + lane] = o; } }
    __syncthreads();
}


#define XB_TMO      128
#define XB_XCNT(j)  (256  + 64 * (j))
#define XB_XSUB(j)  (1280 + 64 * (j))
#define XB_XGEN(j)  (2304 + 64 * (j))
#define XB_TOP      3328
#define XB_TOPGEN   3392
#define XCD_BAR_WORDS 3456
#define XB_SPIN_CAP (1u << 18)

__device__ __forceinline__ unsigned xb_ld(unsigned* p)              { return __hip_atomic_load(p, __ATOMIC_RELAXED, __HIP_MEMORY_SCOPE_AGENT); }
__device__ __forceinline__ unsigned xb_add(unsigned* p, unsigned v) { return __hip_atomic_fetch_add(p, v, __ATOMIC_RELAXED, __HIP_MEMORY_SCOPE_AGENT); }
__device__ __forceinline__ unsigned xb_xcc_id() { return (unsigned)__builtin_amdgcn_s_getreg((3 << 11) | 20) & 0xFu; }
#define XB_SPIN(cond, bar) do { unsigned _sp = 0; while (cond) { __builtin_amdgcn_s_sleep(1); \
    if ((++_sp & 255u) == 0u) { if (xb_ld(&(bar)[XB_TMO])) break; if (_sp > XB_SPIN_CAP) { atomicAdd(&(bar)[XB_TMO], 1u); break; } } } } while (0)

struct XcdBarrier {
    unsigned* bar; unsigned x;
    volatile LAS unsigned* st;
};

__device__ __forceinline__ XcdBarrier xcd_barrier_post(unsigned* bar, volatile LAS unsigned* st) {
    XcdBarrier b; b.bar = bar; b.x = xb_xcc_id(); b.st = st;
    if (threadIdx.x == 0) (void)xb_add(&bar[XB_XCNT(b.x)], 1u);
    return b;
}
__device__ __forceinline__ void xcd_barrier_complete(unsigned* bar, unsigned x, unsigned& nloc, unsigned& nx) {
    const unsigned G = gridDim.x * gridDim.y * gridDim.z;
    unsigned sum, cnt, mine, sp = 0u;
    for (;;) {
        sum = 0u; cnt = 0u; mine = 0u;
#pragma unroll
        for (unsigned j = 0; j < 16; ++j) { const unsigned c = xb_ld(&bar[XB_XCNT(j)]); sum += c; cnt += (c > 0u) ? 1u : 0u; mine = (j == x) ? c : mine; }
        if (sum == G) break;
        __builtin_amdgcn_s_sleep(1);
        if ((++sp & 255u) == 0u) { if (xb_ld(&bar[XB_TMO])) break; if (sp > XB_SPIN_CAP) { atomicAdd(&bar[XB_TMO], 1u); break; } }
    }
    nloc = mine > 0u ? mine : 1u; nx = cnt > 0u ? cnt : 1u;
}

__device__ __forceinline__ void xcd_barrier(const XcdBarrier& b) {
    asm volatile("s_waitcnt vmcnt(0)" ::: "memory");
    __syncthreads();
    if (threadIdx.x == 0) {
        unsigned* bar = b.bar;
        __builtin_amdgcn_s_waitcnt(0);
        unsigned nloc = b.st[0], nx = b.st[1];
        if (nloc == 0u) { xcd_barrier_complete(bar, b.x, nloc, nx); b.st[0] = nloc; b.st[1] = nx; }
        const unsigned old = xb_add(&bar[XB_XSUB(b.x)], 1u);
        const unsigned gen = old / nloc;
        if (old + 1u == (gen + 1u) * nloc) {
            __builtin_amdgcn_fence(__ATOMIC_RELEASE, "agent");
            asm volatile("s_waitcnt vmcnt(0)" ::: "memory");
            const unsigned og = xb_add(&bar[XB_TOP], 1u);
            const unsigned tg = og / nx;
            if (og + 1u == (tg + 1u) * nx) xb_add(&bar[XB_TOPGEN], 1u);
            else XB_SPIN(xb_ld(&bar[XB_TOPGEN]) == tg, bar);
            __builtin_amdgcn_fence(__ATOMIC_ACQUIRE, "agent");
            xb_add(&bar[XB_XGEN(b.x)], 1u);
            asm volatile("s_waitcnt vmcnt(0)" ::: "memory");
        } else {
            XB_SPIN(xb_ld(&bar[XB_XGEN(b.x)]) == gen, bar);
            __builtin_amdgcn_fence(__ATOMIC_ACQUIRE, "agent");
            asm volatile("s_waitcnt vmcnt(0)" ::: "memory");
        }
    }
    __syncthreads();
}

#define barw ((unsigned*)(ws + WS_BAR))
#define rss1 ((float*)(ws + WS_RSS1))
#define rss2 ((float*)(ws + WS_RSS2))
#define rope ((float*)(ws + WS_ROPE))
#define umeta ((float*)(ws + WS_UMETA))
#define lam1 ((float*)(ws + WS_LAM1))
#define lam32 ((float*)(ws + WS_LAM32))
#define BbW ((float*)(ws + WS_BBW))
#define WinT ((bf16*)(ws + WS_WIN))
#define WgluT ((bf16*)(ws + WS_WGLU))
#define PcatT ((bf16*)(ws + WS_PCAT))
#define xnrm ((float*)(ws + WS_XNRM))
#define WoutT ((bf16*)(ws + WS_WOUT))
#define W1T ((bf16*)(ws + WS_W1))
#define W2T ((bf16*)(ws + WS_W2))
#define Mcat ((bf16*)(ws + WS_MCAT))
#define Mstate ((bf16*)(ws + WS_MSTATE))
#define XN ((bf16*)(ws + WS_R1))
#define H1B ((bf16*)(ws + WS_R1))
#define Acat ((bf16*)(ws + WS_ACAT))
#define Sst ((float*)(ws + WS_S))
#define YQO ((bf16*)(ws + WS_YQO))
#define Kb ((bf16*)(ws + WS_K))
#define Vb ((bf16*)(ws + WS_V))
#define Zb ((bf16*)(ws + WS_Z))
#define MRG ((bf16*)(ws + WS_MERGED))
#define HID ((bf16*)(ws + WS_HID))
#define GT ((bf16*)(ws + WS_GATES))
#ifndef PH_MASK
#define PH_MASK 0xFFFF
#endif
#define PH(k) ((PH_MASK >> (k)) & 1)
struct Args { const float* in[23]; float* out; unsigned char* ws; };

__global__ void __launch_bounds__(512, 2) mk_fwd(Args args) {
    extern __shared__ __attribute__((aligned(16))) unsigned char lds[];
    cg::grid_group grid = cg::this_grid();
    const int tid = threadIdx.x, lane = tid & 63, wave = __builtin_amdgcn_readfirstlane(tid >> 6);
    const int G = gridDim.x, bx = blockIdx.x;
    const int vcu = (G % 8 == 0) ? (bx % 8) * (G / 8) + bx / 8 : bx;
    unsigned char* ws = args.ws;
    PG8_LAS unsigned char* L8 = (PG8_LAS unsigned char*)lds;
    volatile LAS unsigned* MISC = (volatile LAS unsigned*)((LAS unsigned char*)lds + (LDS_BYTES - 64));
    if (tid < 16) MISC[tid] = 0u;
    __syncthreads();
    LAS float* Lf = (LAS float*)lds;

#if PH(0)
    if (bx < 32) {
        p0_ssm_setup(Lf, bx, tid, args.in[4], args.in[5], args.in[6], args.in[7], args.in[8], args.in[9], args.in[10], args.in[11], Mcat, Mstate, lam1, lam32, BbW);
    } else if (bx < 48) {
        p0_meta_item(Lf, bx - 32, tid, lane, wave, args.in[1], args.in[2], args.in[3], args.in[15], umeta, Kb, Vb);
    } else if (bx < 64) {
        const int b = (bx - 48) >> 1; unsigned char* T = (unsigned char*)(((bx - 48) & 1) ? Vb : Kb);
        for (int q = 0; q < 3; ++q) { const int idx = tid + 512 * q;
            *(v4u*)(T + ((size_t)b * KVR + SEQ + 16) * 512 + (size_t)idx * 16) = (v4u){0u, 0u, 0u, 0u}; }
    } else if (bx == 64) {
        for (int q = 0; q < 4; ++q) { const int e = tid + 512 * q, pos = e >> 4, j = e & 15; double s, c;
            dsincos_((double)pos * dexp_(-(double)j * (9.21034037197618273607 / 16.0)), s, c); rope[2 * e] = (float)c; rope[2 * e + 1] = (float)s; }
    }
    {
        for (int i = bx * 512 + tid; i < 2 * M; i += G * 512) rss1[i] = 0.f;
        if (bx == 0) for (int i = tid; i < XCD_BAR_WORDS; i += 512) barw[i] = 0u;
        LAS float* scr = (LAS float*)(lds + wave * 16384);
        constexpr int NSPECIAL = 48;
        const int gw = (bx - NSPECIAL) * 8 + wave, NGW = (G - NSPECIAL) * 8;
        if (bx >= NSPECIAL) {
        constexpr int I_IN = (D / 64) * (INW / 32), I_GLU = (SSMW / 64) * (SSMW / 32), I_PS = (SSMW / 64) * (D / 32), I_PA = (D / 64) * (D / 32), I_WO = I_PA, I_1 = (D / 64) * (FF / 32), I_2 = (FF / 64) * (D / 32);
        constexpr int NITEMS = I_IN + I_GLU + I_PS + I_PA + I_WO + I_1 + I_2;
        for (int it = gw; it < NITEMS; it += NGW) {
            int r = it;
            if (r < I_IN) { p0_transpose_item(args.in[3], D, INW, WinT, D, 0, args.in[2], true, scr, r, lane); continue; } r -= I_IN;
            if (r < I_GLU) { p0_transpose_item(args.in[12], SSMW, SSMW, WgluT, SSMW, 0, nullptr, false, scr, r, lane); continue; } r -= I_GLU;
            if (r < I_PS) { p0_transpose_item(args.in[16], SSMW, D, PcatT, QP, 0, nullptr, false, scr, r, lane); continue; } r -= I_PS;
            if (r < I_PA) { p0_transpose_item(args.in[17], D, D, PcatT, QP, SSMW, nullptr, false, scr, r, lane); continue; } r -= I_PA;
            if (r < I_WO) { p0_transpose_item(args.in[18], D, D, WoutT, D, 0, nullptr, false, scr, r, lane); continue; } r -= I_WO;
            if (r < I_1) { p0_transpose_item(args.in[20], D, FF, W1T, D, 0, args.in[19], false, scr, r, lane); continue; } r -= I_1;
            p0_transpose_item(args.in[21], FF, D, W2T, FF, 0, nullptr, false, scr, r, lane);
        }
        for (int m = 2 * gw; m < M; m += 2 * NGW) {
            const int m2 = m + 1;
            const f32x4* xr = (const f32x4*)(args.in[0] + (size_t)m * D) + lane; const f32x4* xr2 = (const f32x4*)(args.in[0] + (size_t)m2 * D) + lane;
            f32x4 v[4], w[4]; float s = 0.f, s2 = 0.f;
#pragma unroll
            for (int j = 0; j < 4; ++j) { v[j] = xr[64 * j]; w[j] = xr2[64 * j]; }
#pragma unroll
            for (int j = 0; j < 4; ++j) { s += (v[j].x * v[j].x + v[j].y * v[j].y) + (v[j].z * v[j].z + v[j].w * v[j].w); s2 += (w[j].x * w[j].x + w[j].y * w[j].y) + (w[j].z * w[j].z + w[j].w * w[j].w); }
            const float rms = sqrtf(wave_sum(s) * (1.0f / D) + NORM_EPS), rms2 = sqrtf(wave_sum(s2) * (1.0f / D) + NORM_EPS), rinv = 1.0f / rms, rinv2 = 1.0f / rms2;
            if (lane == 0) { xnrm[m] = rms; xnrm[m2] = rms2; }
            v2u* o8 = (v2u*)(XN + (size_t)m * D) + lane; v2u* o82 = (v2u*)(XN + (size_t)m2 * D) + lane;
#pragma unroll
            for (int j = 0; j < 4; ++j) { v2u q; q.x = pk2(v[j].x * rinv, v[j].y * rinv); q.y = pk2(v[j].z * rinv, v[j].w * rinv); o8[64 * j] = q;
                v2u q2; q2.x = pk2(w[j].x * rinv2, w[j].y * rinv2); q2.y = pk2(w[j].z * rinv2, w[j].w * rinv2); o82[64 * j] = q2; }
        }
        }
    }
    grid.sync();
    XcdBarrier bar = xcd_barrier_post(barw, MISC + 8);

#endif
#if PH(1)
    {
        pg8::Gemm g{XN, WinT, D, D, D, 0, 0}; pg8::StaticOrder S; S.init(M, INW, G, bx, M / 256);
        pg8::EpiInProj E{Acat, YQO + SSMW, Kb, Vb, GT, args.in[14], args.in[15], rope};
        pg8::gemm_phase<pg8::EpiInProj, pg8::StaticOrder, true, true>(L8, g, S, E);
    }
    xcd_barrier(bar);

#endif
#if PH(2)
    {
        pg8::Gemm g{Acat, Mstate, CT * GP, KCAT, CT * GP, (size_t)CROWS * KCAT, (size_t)256 * 512}; pg8::StaticOrder S; S.init(NGRP * CROWS, 256, G, bx, CROWS / 256);
        pg8::EpiScan E{Acat, lam1, lam32, BbW, umeta};
        pg8::gemm_phase<pg8::EpiScan, pg8::StaticOrder, false, true>(L8, g, S, E);
    }
    {
        const attn_body::AttnTensors AT{(const attn_body::bf16*)(YQO + SSMW), (const attn_body::bf16*)Kb, (const attn_body::bf16*)Vb, (attn_body::bf16*)(YQO + SSMW)};
        const attn_body::StaticOrder S((int)G, (int)bx);
        attn_body::attn_phase<attn_body::StaticOrder>((char*)lds, AT, S);
    }
    xcd_barrier(bar);

#endif
#if PH(4)
    {
        pg8::Gemm g{Acat, Mcat, KCAT, KCAT, KCAT, (size_t)CROWS * KCAT, (size_t)512 * KCAT}; pg8::StaticOrder S; S.init(NGRP * CROWS, 512, G, bx, CROWS / 256);
        pg8::EpiSsmC E{Zb};
        pg8::gemm_phase<pg8::EpiSsmC, pg8::StaticOrder, true, true>(L8, g, S, E);
    }
    xcd_barrier(bar);

#endif
#if PH(5)
    {
        pg8::Gemm g{Zb, WgluT, SSMW, SSMW, SSMW, 0, 0}; pg8::StaticOrder S; S.init(M, SSMW, G, bx, M / 256);
        pg8::EpiEw<0> E{YQO, QP, Zb, SSMW, 0, nullptr, 0, args.in[13]};
        pg8::gemm_phase<pg8::EpiEw<0>, pg8::StaticOrder, true, true>(L8, g, S, E);
    }
    xcd_barrier(bar);

#endif
#if PH(6)
    {
        pg8::Gemm g{YQO, PcatT, QP, QP, QP, 0, 0}; pg8::StaticOrder S; S.init(M, D, G, bx, M / 256);
        pg8::EpiGate E{MRG, GT};
        pg8::gemm_phase<pg8::EpiGate, pg8::StaticOrder, true, true>(L8, g, S, E);
    }
    xcd_barrier(bar);
#endif
#if PH(8)
    {
        pg8::Gemm g{MRG, WoutT, D, D, D, 0, 0}; pg8::StaticOrder S; S.init(M, D, G, bx, M / 256);
        pg8::EpiRes E{H1B, xnrm, rss1};
        pg8::gemm_phase<pg8::EpiRes, pg8::StaticOrder, true, true>(L8, g, S, E);
    }
    xcd_barrier(bar);

#endif
#if PH(9)
    {
        pg8::Gemm g{H1B, W1T, D, D, D, 0, 0}; pg8::StaticOrder S; S.init(M, FF, G, bx, M / 256);
        pg8::EpiEw<5> E{HID, FF, nullptr, 0, 0, nullptr, 0, rss1};
        pg8::gemm_phase<pg8::EpiEw<5>, pg8::StaticOrder, true, true>(L8, g, S, E);
    }
    xcd_barrier(bar);

#endif
#if PH(10)
    {
        pg8::Gemm g{HID, W2T, FF, FF, FF, 0, 0}; pg8::StaticOrder S; S.init(M, D, G, bx, M / 256);
        pg8::EpiRes E{H1B, nullptr, rss2};
        pg8::gemm_phase<pg8::EpiRes, pg8::StaticOrder, true, true>(L8, g, S, E);
    }
    xcd_barrier(bar);

#endif
#if PH(11)
    {
        const float* gf = args.in[22];
        const int gw = vcu * 8 + wave, NGW = G * 8;
        f32x4 gv[4];
#pragma unroll
        for (int j = 0; j < 4; ++j) gv[j] = ((const f32x4*)gf)[64 * j + lane];
        for (int m = gw; m < M; m += 4 * NGW) {
            v2u a[4][4]; float rr[4];
#pragma unroll
            for (int k = 0; k < 4; ++k) { const v2u* h = (const v2u*)(H1B + (size_t)(m + k * NGW) * D) + lane; rr[k] = rss2[m + k * NGW];
#pragma unroll
                for (int j = 0; j < 4; ++j) a[k][j] = h[64 * j]; }
#pragma unroll
            for (int k = 0; k < 4; ++k) { const float ra = 1.0f / sqrtf(rr[k] * (1.0f / D) + NORM_EPS); f32x4* o0 = (f32x4*)(args.out + (size_t)(m + k * NGW) * D) + lane;
#pragma unroll
                for (int j = 0; j < 4; ++j) { f32x4 v = {pg8::bf_lo(a[k][j].x), pg8::bf_hi(a[k][j].x), pg8::bf_lo(a[k][j].y), pg8::bf_hi(a[k][j].y)}; o0[64 * j] = v * ra * gv[j]; } }
        }
    }
#endif
}

extern "C" void kernel_launch(void* const* d_in, const int* in_sizes, int n_in, void* d_out, int out_size, void* d_ws, size_t ws_size, hipStream_t stream) {
    static int grid = 0;
    if (grid == 0) {
        if (n_in != 23 || in_sizes[0] != M * D || in_sizes[3] != D * INW || out_size != M * D || ws_size < WS_END) {
            fprintf(stderr, "kernel_launch: unexpected shapes (n_in %d, in0 %d, in3 %d, out %d, ws %zu); nothing launched\n", n_in, n_in > 0 ? in_sizes[0] : -1, n_in > 3 ? in_sizes[3] : -1, out_size, ws_size); grid = -1; return; }
        int dev = 0, cus = 0, per_cu = 0;
        if (hipGetDevice(&dev) != hipSuccess || hipDeviceGetAttribute(&cus, hipDeviceAttributeMultiprocessorCount, dev) != hipSuccess) { grid = -1; return; }
        if (hipFuncSetAttribute((const void*)mk_fwd, hipFuncAttributeMaxDynamicSharedMemorySize, LDS_BYTES) != hipSuccess) { fprintf(stderr, "kernel_launch: hipFuncSetAttribute failed\n"); grid = -1; return; }
        if (hipOccupancyMaxActiveBlocksPerMultiprocessor(&per_cu, (const void*)mk_fwd, 512, LDS_BYTES) != hipSuccess || per_cu < 1) { fprintf(stderr, "kernel_launch: occupancy query says %d\n", per_cu); per_cu = 1; }
        (void)hipGetLastError();
        grid = cus * per_cu;
        if (grid != 256) { fprintf(stderr, "kernel_launch: this kernel's static schedules need exactly 256 resident workgroups, got %d x %d; nothing launched\n", cus, per_cu); grid = -1; return; }
    }
    if (grid < 0) return;
    Args a{};
    for (int i = 0; i < 23; ++i) a.in[i] = (const float*)d_in[i];
    a.out = (float*)d_out; a.ws = (unsigned char*)d_ws;
    void* kargs[] = {&a};
    const hipError_t e = hipLaunchCooperativeKernel((const void*)mk_fwd, dim3(grid), dim3(512), kargs, LDS_BYTES, stream);
    if (e != hipSuccess) fprintf(stderr, "kernel_launch: cooperative launch failed: %s\n", hipGetErrorString(e));
}
```
